# Optimizing an MI355X kernel written in HIP

```python
import math
import jax, jax.numpy as jnp
from jax import lax
import numpy as np

D_MODEL = 2048
BATCH = 8
SEQ = 2048
DEPTH = 1

GLA_HEADS = 4
GLA_DK = D_MODEL // 2
GLA_DV = D_MODEL
GLA_HK = GLA_DK // GLA_HEADS
GLA_HV = GLA_DV // GLA_HEADS
GLA_RANK = 16
GLA_TAU = 16.0
GLA_CHUNK = 64
FOX_HEADS = 16
FOX_HD = D_MODEL // FOX_HEADS
FOX_BLOCK = 128
FOX_W = FOX_HEADS * FOX_HD
D_FF = 4 * D_MODEL
N_MOD = 6
EPS = 1e-6

IN_SIZES = (GLA_DK, GLA_DK, GLA_DV, GLA_DV, GLA_RANK,
            FOX_W, FOX_W, FOX_W, FOX_HEADS,
            D_MODEL, D_MODEL)
D_IN = 2 * GLA_DK + 2 * GLA_DV + GLA_RANK + 3 * FOX_W + FOX_HEADS + 2 * D_MODEL

kernel_name = "hybrid_gla_fox_adaln_block"


def _split_points():
    return [int(v) for v in np.cumsum(np.array(IN_SIZES))[:-1]]


def rms_norm(x, g):
    xf = x.astype(jnp.float32)
    y = xf * lax.rsqrt(jnp.mean(xf * xf, axis=-1, keepdims=True) + EPS)
    return (y * g.astype(jnp.float32)).astype(x.dtype)


def to_heads(t, n):
    b, s, _ = t.shape
    return t.reshape(b, s, n, -1).transpose(0, 2, 1, 3)


def merge_heads(t):
    b, h, s, d = t.shape
    return t.transpose(0, 2, 1, 3).reshape(b, s, h * d)


def gla_chunked(q, k, v, log_a):
    B, H, S, dk = q.shape
    dv = v.shape[-1]
    n_chunks = S // GLA_CHUNK

    def chunks(t):
        return t.astype(jnp.float32).reshape(B, H, n_chunks, GLA_CHUNK, t.shape[-1]).transpose(2, 0, 1, 3, 4)

    causal = jnp.tril(jnp.ones((GLA_CHUNK, GLA_CHUNK), dtype=bool))

    def step(state, inp):
        qc, kc, vc, lac = inp
        b = jnp.cumsum(lac, axis=-2)
        b_last = b[..., -1:, :]
        q_dec = qc * jnp.exp(b)
        attn = jnp.einsum('bhtd,bhsd->bhts', q_dec, kc * jnp.exp(-b))
        attn = jnp.where(causal, attn, 0.0)
        o = jnp.einsum('bhts,bhsv->bhtv', attn, vc) + jnp.einsum('bhtd,bhdv->bhtv', q_dec, state)
        k_dec = kc * jnp.exp(b_last - b)
        state = state * jnp.swapaxes(jnp.exp(b_last), -1, -2) + jnp.einsum('bhsd,bhsv->bhdv', k_dec, vc)
        return state, o

    state0 = jnp.zeros((B, H, dk, dv), jnp.float32)
    _, o = lax.scan(step, state0, (chunks(q), chunks(k), chunks(v), chunks(log_a)))
    return o.transpose(1, 2, 0, 3, 4).reshape(B, H, S, dv).astype(v.dtype)


def forgetting_attention(q, k, v, log_f):
    S = q.shape[2]
    scale = 1.0 / math.sqrt(q.shape[-1])
    cum = jnp.cumsum(log_f, axis=-1)
    outs = []
    for i in range(S // FOX_BLOCK):
        q0, end = i * FOX_BLOCK, (i + 1) * FOX_BLOCK
        qb = q[:, :, q0:end]
        kb, vb = k[:, :, :end], v[:, :, :end]
        s = jnp.einsum('bhtd,bhsd->bhts', qb, kb).astype(jnp.float32) * scale
        s = s + cum[:, :, q0:end, None] - cum[:, :, None, :end]
        qpos = jnp.arange(q0, end)[:, None]
        kpos = jnp.arange(end)[None, :]
        s = jnp.where(kpos <= qpos, s, -jnp.inf)
        p = jax.nn.softmax(s, axis=-1).astype(v.dtype)
        outs.append(jnp.einsum('bhts,bhsd->bhtd', p, vb))
    return jnp.concatenate(outs, axis=2)


def setup_inputs(seed: int = 0) -> dict:
    key = jax.random.key(seed)
    ks = jax.random.split(key, 20)
    f32 = jnp.float32
    nrm = lambda k, shape, s: jax.random.normal(k, shape, f32) * s
    D = D_MODEL
    return {
        "x": nrm(ks[0], (BATCH, SEQ, D), 1.0),
        "c": nrm(ks[1], (BATCH, D), 1.0),
        "w_ada": nrm(ks[2], (DEPTH, D, N_MOD * D), 0.5 * D ** -0.5),
        "b_ada": nrm(ks[3], (DEPTH, N_MOD * D), 0.01),
        "g_norm1": 1.0 + nrm(ks[4], (DEPTH, D), 0.05),
        "w_in": nrm(ks[5], (DEPTH, D, D_IN), D ** -0.5),
        "w_gla_a_up": nrm(ks[6], (DEPTH, GLA_RANK, GLA_DK), GLA_RANK ** -0.5),
        "b_gla_a": 1.0 + nrm(ks[7], (DEPTH, GLA_DK), 0.5),
        "g_gla_out": 1.0 + nrm(ks[8], (DEPTH, GLA_HV), 0.05),
        "b_fox_f": 2.0 + nrm(ks[9], (DEPTH, FOX_HEADS), 1.0),
        "w_proj_gla": nrm(ks[10], (DEPTH, GLA_DV, D), GLA_DV ** -0.5),
        "w_proj_fox": nrm(ks[11], (DEPTH, FOX_W, D), FOX_W ** -0.5),
        "w_out": nrm(ks[12], (DEPTH, D, D), D ** -0.5),
        "g_norm2": 1.0 + nrm(ks[13], (DEPTH, D), 0.05),
        "w_ff1": nrm(ks[14], (DEPTH, D, D_FF), D ** -0.5),
        "w_ff2": nrm(ks[15], (DEPTH, D_FF, D), D_FF ** -0.5),
        "g_final": 1.0 + nrm(ks[16], (D,), 0.05),
    }


def reference(x, c, w_ada, b_ada, g_norm1, w_in, w_gla_a_up, b_gla_a, g_gla_out, b_fox_f,
              w_proj_gla, w_proj_fox, w_out, g_norm2, w_ff1, w_ff2, g_final):
    cond = jax.nn.silu(c)
    split_pts = _split_points()
    for l in range(DEPTH):
        mod = (cond @ w_ada[l] + b_ada[l])[:, None, :]
        shift1, scale1, gate1, shift2, scale2, gate2 = jnp.split(mod, N_MOD, axis=-1)

        h = rms_norm(x, g_norm1[l]) * (1.0 + scale1) + shift1
        proj = h @ w_in[l]
        (gq, gk, gv, gg, ga_low, fq, fk, fv, f_logit, gate_a, gate_b) = jnp.split(proj, split_pts, axis=-1)

        log_a = jax.nn.log_sigmoid((ga_low @ w_gla_a_up[l] + b_gla_a[l]).astype(jnp.float32)) / GLA_TAU
        o_a = gla_chunked(to_heads(gq * (GLA_HK ** -0.5), GLA_HEADS), to_heads(gk, GLA_HEADS),
                          to_heads(gv, GLA_HEADS), to_heads(log_a, GLA_HEADS))
        o_a = merge_heads(rms_norm(o_a, g_gla_out[l])) * jax.nn.silu(gg)

        log_f = jax.nn.log_sigmoid((f_logit + b_fox_f[l]).astype(jnp.float32)).transpose(0, 2, 1)
        o_b = merge_heads(forgetting_attention(to_heads(fq, FOX_HEADS), to_heads(fk, FOX_HEADS),
                                               to_heads(fv, FOX_HEADS), log_f))

        merged = jax.nn.sigmoid(gate_a) * (o_a @ w_proj_gla[l]) + jax.nn.sigmoid(gate_b) * (o_b @ w_proj_fox[l])
        x = x + gate1 * (merged @ w_out[l])

        h2 = rms_norm(x, g_norm2[l]) * (1.0 + scale2) + shift2
        x = x + gate2 * (jnp.square(jax.nn.relu(h2 @ w_ff1[l])) @ w_ff2[l])
    return rms_norm(x, g_final)
```

```cpp
#include <hip/hip_runtime.h>
#include <hip/hip_cooperative_groups.h>
#include <cstdio>
#include <cstdint>
namespace cg = cooperative_groups;
namespace pg8 {
#define PG8_LAS __attribute__((address_space(3)))
typedef unsigned short bf16_t;
typedef short bf16x8 __attribute__((ext_vector_type(8)));
typedef float f32x4 __attribute__((ext_vector_type(4)));
typedef unsigned u32x4 __attribute__((ext_vector_type(4)));
constexpr int BM = 256, BK = 64, HALF = 128, HTB = HALF * BK * 2  , STAGE_BYTES = 8 * HTB, NXCD = 8, WGM = 4;

__host__ __device__ __forceinline__ int lds_byte(int r, int c) { const int st = (r >> 4) * 2 + (c >> 5), rr = r & 15, cc = c & 31, ob = rr * 64 + cc * 2; return st * 1024 + (ob ^ (((ob >> 9) & 1) << 5)); }
__host__ __device__ __forceinline__ void stage_rc(int b, int& R, int& C) { const int st = b / 1024, sb = b % 1024, swz = sb ^ (((sb >> 9) & 1) << 5); R = (st >> 1) * 16 + swz / 64; C = (st & 1) * 32 + (swz % 64) / 2; }
__host__ __device__ __forceinline__ int perm32(int rho) { const int n = rho >> 4, i = rho & 15; return 8 * (i >> 2) + 4 * n + (i & 3); }

struct Unit { int pm, pn, z; };
struct Gemm { const bf16_t* A; const bf16_t* Bt; int M, N, K; const bf16_t* A2; const bf16_t* Bt2; };

struct StaticOrder {
    int nM, nN, nwg, G, c, wgm;
    __host__ __device__ void init(int M, int N, int G_, int c_, int wgm_ = WGM) { nM = M / BM; nN = N / BM; nwg = nM * nN; G = G_; c = c_; wgm = wgm_; }
    __host__ __device__ bool next(int i, Unit& u) const {
        const long L = (long)i * G + c; if (L >= nwg) return false;
        int wgid = (int)L; { const int q = nwg / NXCD, r = nwg % NXCD, xcd = wgid % NXCD, off = wgid / NXCD; wgid = (xcd < r ? xcd * (q + 1) : r * (q + 1) + (xcd - r) * q) + off; }
        const int nig = wgm * nN, gid = wgid / nig, fm = gid * wgm, gsz = (nM - fm) < wgm ? (nM - fm) : wgm;
        u.pm = fm + ((wgid % nig) % gsz); u.pn = (wgid % nig) / gsz; u.z = 0; return true;
    }
    __device__ __forceinline__ void a_ready(const Unit&) const {}
    __device__ __forceinline__ void done(const Unit&) const {}
};
struct DualOrder {
    StaticOrder base;
    __host__ __device__ void init(int M, int N, int G_, int c_, int wgm_ = WGM) { base.init(M, N, G_, c_, wgm_); }
    __host__ __device__ bool next(int i, Unit& u) const { if (!base.next(i >> 1, u)) return false; u.z = i & 1; return true; }
    __device__ __forceinline__ void a_ready(const Unit&) const {}
    __device__ __forceinline__ void done(const Unit&) const {}
};

__device__ __forceinline__ unsigned cvt_pk_bf16(float lo, float hi) { unsigned r; asm volatile("v_cvt_pk_bf16_f32 %0, %1, %2" : "=v"(r) : "v"(lo), "v"(hi)); return r; }
typedef float f32x2 __attribute__((ext_vector_type(2)));
template <class Epi, class Sched, bool ALIGN_EPI = false, bool SP2 = false>
__device__ __forceinline__ void gemm_phase(PG8_LAS unsigned char* lds, const Gemm g, const Sched& S, const Epi& E, int tid_in) {
    int tid_l = tid_in; asm volatile("" : "+v"(tid_l)); const int tid = tid_l, wid = __builtin_amdgcn_readfirstlane(tid >> 6), lane = tid & 63, wr = wid >> 2, wc = wid & 3, fr = lane & 15, fq = lane >> 4;
    const int K = g.K, nt = K / BK;
    unsigned voffA[2], voffB[2];
#pragma unroll
    for (int i = 0; i < 2; ++i) { int R, C; stage_rc(tid * 16 + i * 8192, R, C); const int Rb = Epi::PERM ? ((R & ~31) + perm32(R & 31)) : R;
        voffA[i] = (unsigned)(R * K + C) * 2u; voffB[i] = (unsigned)(Rb * K + C) * 2u; }
    const size_t kstep = (size_t)(BK * 2);
    const size_t hstep = (size_t)HALF * K * 2;
    const size_t tstep = 2 * hstep;
    const unsigned ldsw = (unsigned)wid * 1024u;
    const int aoff = lds_byte(wr * 64 + fr, fq * 8), boff = lds_byte(wc * 32 + fr, fq * 8);
#define PG8_SA(b, h) (((b) * 2 + (h)) * HTB)
#define PG8_SB(b, h) ((4 + (b) * 2 + (h)) * HTB)
#define PG8_STAGE(bufoff, gbase, voff) do { _Pragma("unroll") for (int _i = 0; _i < 2; ++_i) \
        __builtin_amdgcn_global_load_lds((const unsigned*)((const char*)(gbase) + (voff)[_i]), (PG8_LAS unsigned*)(lds + (bufoff) + ldsw + _i * 8192), 16, 0, 0); } while (0)
#define PG8_LDA(dst, b, h) do { _Pragma("unroll") for (int m = 0; m < 4; ++m) _Pragma("unroll") for (int k = 0; k < 2; ++k) dst[m][k] = *(const PG8_LAS bf16x8*)(lds + PG8_SA(b, h) + aoff + m * 2048 + k * 1024); } while (0)
#define PG8_LDB(dst, b, h) do { _Pragma("unroll") for (int n = 0; n < 2; ++n) _Pragma("unroll") for (int k = 0; k < 2; ++k) dst[n][k] = *(const PG8_LAS bf16x8*)(lds + PG8_SB(b, h) + boff + n * 2048 + k * 1024); } while (0)
#define PG8_MMA(ai, bj, At, Bt) do { __builtin_amdgcn_s_setprio(1); _Pragma("unroll") for (int m = 0; m < 4; ++m) _Pragma("unroll") for (int n = 0; n < 2; ++n) _Pragma("unroll") for (int k = 0; k < 2; ++k) \
        acc[ai][bj][m][n] = __builtin_amdgcn_mfma_f32_16x16x32_bf16(Bt[n][k], At[m][k], acc[ai][bj][m][n], 0, 0, 0); __builtin_amdgcn_s_setprio(0); } while (0)
#define PG8_WAIT_V(n) asm volatile("s_waitcnt vmcnt(" #n ")" ::: "memory")
#define PG8_WAIT_L(n) asm volatile("s_waitcnt lgkmcnt(" #n ")" ::: "memory")
#define PG8_BAR __builtin_amdgcn_s_barrier()
#define PG8_SCHED __builtin_amdgcn_sched_barrier(0)
    Unit cur, nxt; int ui = 0;
    if (!S.next(0, cur)) return;
    f32x4 acc[2][2][4][2];
#pragma unroll
    for (int a = 0; a < 2; ++a)
#pragma unroll
        for (int b = 0; b < 2; ++b)
#pragma unroll
            for (int m = 0; m < 4; ++m)
#pragma unroll
                for (int n = 0; n < 2; ++n) acc[a][b][m][n] = (f32x4){0.f, 0.f, 0.f, 0.f};
    bf16x8 At[4][2], B0[2][2], B1[2][2];
    const char* cA = (const char*)(cur.z ? g.A2 : g.A) + (size_t)cur.pm * tstep; const char* cB = (const char*)(cur.z ? g.Bt2 : g.Bt) + (size_t)cur.pn * tstep;
    S.a_ready(cur);
    if constexpr (SP2) {
        PG8_STAGE(PG8_SB(0, 0), cB, voffB); PG8_STAGE(PG8_SB(0, 1), cB + hstep, voffB); PG8_STAGE(PG8_SA(0, 0), cA, voffA); PG8_STAGE(PG8_SA(0, 1), cA + hstep, voffA);
        if (wr == 1) PG8_BAR;
        PG8_WAIT_V(2); PG8_BAR;
        PG8_STAGE(PG8_SB(1, 0), cB + kstep, voffB); PG8_STAGE(PG8_SA(1, 0), cA + kstep, voffA); PG8_STAGE(PG8_SB(1, 1), cB + hstep + kstep, voffB);
        PG8_WAIT_V(6); PG8_BAR;
    } else {
        PG8_STAGE(PG8_SB(0, 0), cB, voffB); PG8_STAGE(PG8_SA(0, 0), cA, voffA); PG8_STAGE(PG8_SB(0, 1), cB + hstep, voffB); PG8_STAGE(PG8_SA(0, 1), cA + hstep, voffA);
        if (wr == 1) PG8_BAR;
        PG8_WAIT_V(4); PG8_BAR;
        PG8_STAGE(PG8_SB(1, 0), cB + kstep, voffB); PG8_STAGE(PG8_SA(1, 0), cA + kstep, voffA); PG8_STAGE(PG8_SB(1, 1), cB + hstep + kstep, voffB);
        PG8_WAIT_V(6); PG8_BAR;
    }
    for (;;) {
        const bool has_next = S.next(ui + 1, nxt);
        const char* nA = has_next ? (const char*)(nxt.z ? g.A2 : g.A) + (size_t)nxt.pm * tstep : cA; const char* nB = has_next ? (const char*)(nxt.z ? g.Bt2 : g.Bt) + (size_t)nxt.pn * tstep : cB;
        for (int t = 0; t < nt; t += 2) {
            const bool last = (t == nt - 2);
            const char* a1 = cA + (size_t)(t + 1) * kstep;
            const char* a2 = last ? nA : cA + (size_t)(t + 2) * kstep; const char* b2 = last ? nB : cB + (size_t)(t + 2) * kstep;
            const char* a3 = a2 + kstep; const char* b3 = b2 + kstep;
            if (last && has_next) S.a_ready(nxt);
            if constexpr (SP2) {
            PG8_LDB(B0, 0, 0); PG8_LDB(B1, 0, 1); PG8_SCHED; PG8_LDA(At, 0, 0); PG8_STAGE(PG8_SA(1, 1), a1 + hstep, voffA);
            PG8_WAIT_V(8); PG8_WAIT_L(0); PG8_BAR; PG8_MMA(0, 0, At, B0); PG8_MMA(0, 1, At, B1); PG8_BAR; PG8_SCHED;
            PG8_LDA(At, 0, 1); PG8_STAGE(PG8_SB(0, 0), b2, voffB); PG8_STAGE(PG8_SB(0, 1), b2 + hstep, voffB); PG8_STAGE(PG8_SA(0, 0), a2, voffA);
            PG8_WAIT_V(8); PG8_WAIT_L(0); PG8_BAR; PG8_MMA(1, 0, At, B0); PG8_MMA(1, 1, At, B1); PG8_BAR; PG8_SCHED;
            PG8_LDB(B0, 1, 0); PG8_LDB(B1, 1, 1); PG8_SCHED; PG8_LDA(At, 1, 0); PG8_STAGE(PG8_SA(0, 1), a2 + hstep, voffA);
            PG8_WAIT_V(8); PG8_WAIT_L(0); PG8_BAR; PG8_MMA(0, 0, At, B0); PG8_MMA(0, 1, At, B1); PG8_BAR; PG8_SCHED;
            PG8_LDA(At, 1, 1); PG8_STAGE(PG8_SB(1, 0), b3, voffB); PG8_STAGE(PG8_SB(1, 1), b3 + hstep, voffB); PG8_STAGE(PG8_SA(1, 0), a3, voffA);
            PG8_WAIT_V(8); PG8_WAIT_L(0); PG8_BAR; PG8_MMA(1, 0, At, B0); PG8_MMA(1, 1, At, B1); PG8_BAR; PG8_SCHED;
            } else {
            PG8_LDB(B0, 0, 0); PG8_SCHED; PG8_LDA(At, 0, 0); PG8_STAGE(PG8_SA(1, 1), a1 + hstep, voffA);
            PG8_WAIT_L(8); PG8_BAR; PG8_WAIT_L(0); PG8_MMA(0, 0, At, B0); PG8_BAR; PG8_SCHED;
            PG8_LDB(B1, 0, 1); PG8_STAGE(PG8_SB(0, 0), b2, voffB);
            PG8_BAR; PG8_WAIT_L(0); PG8_MMA(0, 1, At, B1); PG8_BAR;
            PG8_LDA(At, 0, 1); PG8_STAGE(PG8_SA(0, 0), a2, voffA);
            PG8_BAR; PG8_WAIT_L(0); PG8_MMA(1, 0, At, B0); PG8_BAR; PG8_SCHED;
            PG8_STAGE(PG8_SB(0, 1), b2 + hstep, voffB);
            PG8_WAIT_V(6); PG8_BAR; PG8_MMA(1, 1, At, B1); PG8_BAR;
            PG8_LDB(B0, 1, 0); PG8_SCHED; PG8_LDA(At, 1, 0); PG8_STAGE(PG8_SA(0, 1), a2 + hstep, voffA);
            PG8_WAIT_L(8); PG8_BAR; PG8_WAIT_L(0); PG8_MMA(0, 0, At, B0); PG8_BAR; PG8_SCHED;
            PG8_LDB(B1, 1, 1); PG8_STAGE(PG8_SB(1, 0), b3, voffB);
            PG8_BAR; PG8_WAIT_L(0); PG8_MMA(0, 1, At, B1); PG8_BAR;
            PG8_LDA(At, 1, 1); PG8_STAGE(PG8_SA(1, 0), a3, voffA);
            PG8_BAR; PG8_WAIT_L(0); PG8_MMA(1, 0, At, B0); PG8_BAR; PG8_SCHED;
            PG8_STAGE(PG8_SB(1, 1), b3 + hstep, voffB);
            PG8_WAIT_V(6); PG8_BAR; PG8_MMA(1, 1, At, B1); PG8_BAR;
            }
        }
        if constexpr (ALIGN_EPI) { if (wr == 0) PG8_BAR; }
        if constexpr (!Epi::AFTER_DRAIN) { if constexpr (Epi::DUAL || Epi::MUT) E.dual(acc, cur, wr, wc, fr, fq); else E(acc, cur, wr, wc, fr, fq); S.done(cur); }
        if (!has_next) break;
        if (!(Epi::DUAL && cur.z == 0))
#pragma unroll
        for (int a = 0; a < 2; ++a)
#pragma unroll
            for (int b = 0; b < 2; ++b)
#pragma unroll
                for (int m = 0; m < 4; ++m)
#pragma unroll
                    for (int n = 0; n < 2; ++n) acc[a][b][m][n] = (f32x4){0.f, 0.f, 0.f, 0.f};
        cur = nxt; cA = nA; cB = nB; ++ui;
        if constexpr (ALIGN_EPI) { if (wr == 1) PG8_BAR; }
    }
    PG8_WAIT_V(0);
    if constexpr (!ALIGN_EPI) { if (wr == 0) PG8_BAR; }
    PG8_BAR;
    if constexpr (Epi::AFTER_DRAIN) { E.fused(acc, cur, wr, wc, fr, fq, lds, wid, lane); S.done(cur); }
#undef PG8_SA
#undef PG8_SB
#undef PG8_STAGE
#undef PG8_LDA
#undef PG8_LDB
#undef PG8_MMA
#undef PG8_WAIT_V
#undef PG8_WAIT_L
#undef PG8_BAR
#undef PG8_SCHED
}
}

#define LAS __attribute__((address_space(3)))
typedef unsigned short bf16;
typedef float f32x4 __attribute__((ext_vector_type(4)));
typedef float f32x2 __attribute__((ext_vector_type(2)));
typedef short bf16x8 __attribute__((ext_vector_type(8)));
typedef short s16x4 __attribute__((ext_vector_type(4)));
typedef unsigned u32x4 __attribute__((ext_vector_type(4)));
typedef unsigned u32x2 __attribute__((ext_vector_type(2)));

constexpr int DM = 2048, NB = 8, SEQ = 2048, MT = NB * SEQ, DIN = 16416, DFF = 8192, NMOD = 6 * DM;
constexpr int N1A = 12288, N1B = 4096;
constexpr float EPS = 1e-6f;
constexpr size_t MiB = 1u << 20;
constexpr size_t WS_MODP = 0, WS_WINLO = 12 * MiB, WS_OA = 0, WS_WINHI = 64 * MiB, WS_MOD = 80 * MiB, WS_SMALL = 81 * MiB, WS_CTL = 83 * MiB, WS_ROWSS = 83 * MiB + 65536, WS_PCNT = 83 * MiB + 196608;
constexpr size_t WS_WA = 84 * MiB, WS_WB = 92 * MiB, WS_WO = 100 * MiB;
constexpr size_t WS_GQ = 108 * MiB, WS_GK = 140 * MiB, WS_GVT = 172 * MiB, WS_GG = 236 * MiB, WS_FQ = 300 * MiB, WS_FK = 364 * MiB, WS_FVT = 428 * MiB, WS_KDTG = 492 * MiB, WS_EBLG = 524 * MiB, WS_CUMG = 525 * MiB, WS_END = 526 * MiB;
constexpr size_t WS_SGA = 108 * MiB, WS_SGB = 300 * MiB, WS_W1 = 172 * MiB, WS_W2 = 204 * MiB, WS_T = 364 * MiB, WS_MG = 236 * MiB, WS_H2 = 108 * MiB, WS_U = 236 * MiB, WS_X2B = 108 * MiB, WS_X1B = 0;
constexpr int LDS_BYTES = 150 * 1024;

struct Args { const float* in[17]; float* out; unsigned char* ws; };

__device__ __forceinline__ unsigned f2bf(float f) { unsigned u = __builtin_bit_cast(unsigned, f); return (u + 0x7fffu + ((u >> 16) & 1u)) >> 16; }
typedef __bf16 bf16x2_t __attribute__((ext_vector_type(2)));
__device__ __forceinline__ unsigned pk2(float lo, float hi) { const f32x2 v = {lo, hi}; const bf16x2_t b = __builtin_convertvector(v, bf16x2_t); return __builtin_bit_cast(unsigned, b); }
__device__ __forceinline__ float bf2f(unsigned short v) { return __builtin_bit_cast(float, (unsigned)v << 16); }
__device__ __forceinline__ float bflo(unsigned w) { return __builtin_bit_cast(float, w << 16); }
__device__ __forceinline__ float bfhi(unsigned w) { return __builtin_bit_cast(float, w & 0xffff0000u); }
__device__ __forceinline__ float shx(float v, int o, int lane) { return __builtin_bit_cast(float, __builtin_amdgcn_ds_bpermute((lane ^ o) << 2, __builtin_bit_cast(int, v))); }
__device__ __forceinline__ float wave_sum(float v, int lane) {
#pragma unroll
    for (int o = 1; o < 64; o <<= 1) v += shx(v, o, lane);
    return v;
}
__device__ __forceinline__ float logsig(float z) { return fminf(z, 0.f) - __logf(1.f + __expf(-fabsf(z))); }
__device__ __forceinline__ float sigmoidf_(float z) { return __builtin_amdgcn_rcpf(1.f + __expf(-z)); }
template <int CTRL> __device__ __forceinline__ unsigned dppu(unsigned x) { return (unsigned)__builtin_amdgcn_mov_dpp((int)x, CTRL, 0xF, 0xF, true); }
template <int CTRL> __device__ __forceinline__ float dppx(float x) { return __builtin_bit_cast(float, __builtin_amdgcn_mov_dpp(__builtin_bit_cast(int, x), CTRL, 0xF, 0xF, true)); }
#define LDS_WAIT() asm volatile("s_waitcnt lgkmcnt(0)" ::: "memory")

struct EpiProj {
    static constexpr bool PERM = true, AFTER_DRAIN = false, DUAL = false, MUT = false;
    unsigned char* ws;
    __device__ __forceinline__ void operator()(const f32x4 (&acc)[2][2][4][2], const pg8::Unit& u, int wr, int wc, int fr, int fq) const {
        const int pn = u.pn, row0 = u.pm * 256 + wr * 64 + fr, cin = wc * 32 + 8 * fq;
        if (pn == 48) {
            if (wc == 0) { float* S = (float*)(ws + WS_SMALL);
#pragma unroll
                for (int ai = 0; ai < 2; ++ai)
#pragma unroll
                    for (int m = 0; m < 4; ++m) { float* p = S + (size_t)(row0 + ai * 128 + m * 16) * 32 + 8 * fq; *(f32x4*)p = acc[ai][0][m][0]; *(f32x4*)(p + 4) = acc[ai][0][m][1]; } }
            return;
        }
        const bool tr = (pn >= 8 && pn < 16) || pn >= 40;
        if (!tr) {
            bf16* base; int ld, c0;
            if (pn < 4) { base = (bf16*)(ws + WS_GQ); ld = 1024; c0 = pn * 256; }
            else if (pn < 8) { base = (bf16*)(ws + WS_GK); ld = 1024; c0 = (pn - 4) * 256; }
            else if (pn < 24) { base = (bf16*)(ws + WS_GG); ld = 2048; c0 = (pn - 16) * 256; }
            else if (pn < 32) { base = (bf16*)(ws + WS_FQ); ld = 2048; c0 = (pn - 24) * 256; }
            else { base = (bf16*)(ws + WS_FK); ld = 2048; c0 = (pn - 32) * 256; }
#pragma unroll
            for (int ai = 0; ai < 2; ++ai)
#pragma unroll
                for (int m = 0; m < 4; ++m) { bf16* rp = base + (size_t)(row0 + ai * 128 + m * 16) * ld + c0 + cin;
#pragma unroll
                    for (int bj = 0; bj < 2; ++bj) { const f32x4 v0 = acc[ai][bj][m][0], v1 = acc[ai][bj][m][1];
                        u32x4 w; w.x = pk2(v0[0], v0[1]); w.y = pk2(v0[2], v0[3]); w.z = pk2(v1[0], v1[1]); w.w = pk2(v1[2], v1[3]);
                        *(u32x4*)(rp + bj * 128) = w; } }
        } else {
            bf16* base = (bf16*)(ws + (pn < 16 ? WS_GVT : WS_FVT)); const int c0 = (pn < 16 ? pn - 8 : pn - 40) * 256;
            const int b = (u.pm * 256) / SEQ, blk0 = ((u.pm * 256) % SEQ) / 64 + wr, jq = fr & 3;
            const bool b0 = (jq & 1) != 0, b1 = (jq & 2) != 0;
            const int sn = 16 * jq + 4 * (fr >> 2); const int s = pn < 16 ? sn : ((sn & ~31) | (((sn >> 2) & 3) << 3) | (((sn >> 4) & 1) << 2));
            bf16* bb = base + (((size_t)b * 32 + blk0) * DM + c0 + cin) * 64 + s;
#pragma unroll
            for (int ai = 0; ai < 2; ++ai)
#pragma unroll
                for (int bj = 0; bj < 2; ++bj)
#pragma unroll
                    for (int n = 0; n < 2; ++n) { unsigned wx[4], wy[4];
#pragma unroll
                        for (int m = 0; m < 4; ++m) { float r0 = acc[ai][bj][m][n][0], r1 = acc[ai][bj][m][n][1], r2 = acc[ai][bj][m][n][2], r3 = acc[ai][bj][m][n][3];
                            { const float x = b0 ? r0 : r1, y = dppx<0xB1>(x); if (b0) r0 = y; else r1 = y; }
                            { const float x = b0 ? r2 : r3, y = dppx<0xB1>(x); if (b0) r2 = y; else r3 = y; }
                            { const float x = b1 ? r0 : r2, y = dppx<0x4E>(x); if (b1) r0 = y; else r2 = y; }
                            { const float x = b1 ? r1 : r3, y = dppx<0x4E>(x); if (b1) r1 = y; else r3 = y; }
                            wx[m] = pk2(r0, r1); wy[m] = pk2(r2, r3); }
                        { const unsigned x = b0 ? wx[0] : wx[1], y = dppu<0xB1>(x); if (b0) wx[0] = y; else wx[1] = y; }
                        { const unsigned x = b0 ? wx[2] : wx[3], y = dppu<0xB1>(x); if (b0) wx[2] = y; else wx[3] = y; }
                        { const unsigned x = b1 ? wx[0] : wx[2], y = dppu<0x4E>(x); if (b1) wx[0] = y; else wx[2] = y; }
                        { const unsigned x = b1 ? wx[1] : wx[3], y = dppu<0x4E>(x); if (b1) wx[1] = y; else wx[3] = y; }
                        { const unsigned x = b0 ? wy[0] : wy[1], y = dppu<0xB1>(x); if (b0) wy[0] = y; else wy[1] = y; }
                        { const unsigned x = b0 ? wy[2] : wy[3], y = dppu<0xB1>(x); if (b0) wy[2] = y; else wy[3] = y; }
                        { const unsigned x = b1 ? wy[0] : wy[2], y = dppu<0x4E>(x); if (b1) wy[0] = y; else wy[2] = y; }
                        { const unsigned x = b1 ? wy[1] : wy[3], y = dppu<0x4E>(x); if (b1) wy[1] = y; else wy[3] = y; }
#pragma unroll
                        for (int mc = 0; mc < 4; ++mc) { u32x2 w; w.x = wx[mc]; w.y = wy[mc];
                            *(u32x2*)(bb + ((size_t)(2 * ai) * DM + bj * 128 + 4 * n + mc) * 64) = w; } }
        }
    }
};
template <int MODE> struct EpiGen {
    static constexpr bool PERM = true, AFTER_DRAIN = false, DUAL = false, MUT = false;
    bf16* ob; int ldo; const bf16* gb; float* tf; const float* xin; float* xout; const float* gate;
    __device__ __forceinline__ void operator()(const f32x4 (&acc)[2][2][4][2], const pg8::Unit& u, int wr, int wc, int fr, int fq) const {
        const int row0 = u.pm * 256 + wr * 64 + fr; int col0 = u.pn * 256 + wc * 32 + 8 * fq;
        bf16* obase = ob;
        if (MODE == 0) { if (u.pn >= 8) { obase = (bf16*)((unsigned char*)ob + (WS_SGB - WS_SGA)); col0 -= 2048; } }
        f32x4 g0[2], g1[2];
        if (MODE == 3 || MODE == 5 || MODE == 6) { const float* gp = gate + (size_t)((u.pm * 256) / SEQ) * NMOD + col0;
#pragma unroll
            for (int bj = 0; bj < 2; ++bj) { g0[bj] = *(const f32x4*)(gp + bj * 128); g1[bj] = *(const f32x4*)(gp + bj * 128 + 4); } }
#pragma unroll
        for (int aq = 0; aq < 4; ++aq) { const int ai = aq >> 1, mh = aq & 1;
            u32x4 gw[2][2]; f32x4 p0[2][2], p1[2][2];
            if (MODE == 1 || MODE == 2 || MODE == 3 || MODE == 5 || MODE == 6) {
#pragma unroll
                for (int m2 = 0; m2 < 2; ++m2) { const size_t row = (size_t)(row0 + ai * 128 + (2 * mh + m2) * 16);
#pragma unroll
                    for (int bj = 0; bj < 2; ++bj) { const int col = col0 + bj * 128;
                        if (MODE == 1 || MODE == 2 || MODE == 6) gw[m2][bj] = *(const u32x4*)(gb + row * 2048 + col);
                        if (MODE == 2) { p0[m2][bj] = *(const f32x4*)(tf + row * 2048 + col); p1[m2][bj] = *(const f32x4*)(tf + row * 2048 + col + 4); }
                        if (MODE == 3 || MODE == 5) { p0[m2][bj] = *(const f32x4*)(xin + row * 2048 + col); p1[m2][bj] = *(const f32x4*)(xin + row * 2048 + col + 4); } } }
                __builtin_amdgcn_sched_barrier(0); }
#pragma unroll
            for (int m2 = 0; m2 < 2; ++m2) { const int m = 2 * mh + m2; const size_t row = (size_t)(row0 + ai * 128 + m * 16);
#pragma unroll
                for (int bj = 0; bj < 2; ++bj) { f32x4 v0 = acc[ai][bj][m][0], v1 = acc[ai][bj][m][1]; const int col = col0 + bj * 128;
                    if (MODE == 0) {
#pragma unroll
                        for (int e = 0; e < 4; ++e) { v0[e] = sigmoidf_(v0[e]); v1[e] = sigmoidf_(v1[e]); }
                        u32x4 w; w.x = pk2(v0[0], v0[1]); w.y = pk2(v0[2], v0[3]); w.z = pk2(v1[0], v1[1]); w.w = pk2(v1[2], v1[3]);
                        *(u32x4*)(obase + row * ldo + col) = w;
                    } else if (MODE == 1 || MODE == 2) {
                        const u32x4 g = gw[m2][bj];
                        const f32x4 s0 = {bflo(g.x), bfhi(g.x), bflo(g.y), bfhi(g.y)}, s1 = {bflo(g.z), bfhi(g.z), bflo(g.w), bfhi(g.w)};
                        float* tp = tf + row * 2048 + col;
                        if (MODE == 1) { *(f32x4*)tp = s0 * v0; *(f32x4*)(tp + 4) = s1 * v1; }
                        else { v0 = p0[m2][bj] + s0 * v0; v1 = p1[m2][bj] + s1 * v1;
                            u32x4 w; w.x = pk2(v0[0], v0[1]); w.y = pk2(v0[2], v0[3]); w.z = pk2(v1[0], v1[1]); w.w = pk2(v1[2], v1[3]);
                            *(u32x4*)(obase + row * ldo + col) = w; }
                    } else if (MODE == 3) {
                        float* op = xout + row * 2048 + col;
                        *(f32x4*)op = p0[m2][bj] + g0[bj] * v0; *(f32x4*)(op + 4) = p1[m2][bj] + g1[bj] * v1;
                    } else if (MODE == 5 || MODE == 6) {
                        f32x4 x0, x1;
                        if (MODE == 5) { x0 = p0[m2][bj]; x1 = p1[m2][bj]; }
                        else { const u32x4 g = gw[m2][bj]; x0 = (f32x4){bflo(g.x), bfhi(g.x), bflo(g.y), bfhi(g.y)}; x1 = (f32x4){bflo(g.z), bfhi(g.z), bflo(g.w), bfhi(g.w)}; }
                        v0 = x0 + g0[bj] * v0; v1 = x1 + g1[bj] * v1;
                        u32x4 w; w.x = pk2(v0[0], v0[1]); w.y = pk2(v0[2], v0[3]); w.z = pk2(v1[0], v1[1]); w.w = pk2(v1[2], v1[3]);
                        *(u32x4*)(obase + row * ldo + col) = w;
                    } else {
#pragma unroll
                        for (int e = 0; e < 4; ++e) { const float a = fmaxf(v0[e], 0.f), c = fmaxf(v1[e], 0.f); v0[e] = a * a; v1[e] = c * c; }
                        u32x4 w; w.x = pk2(v0[0], v0[1]); w.y = pk2(v0[2], v0[3]); w.z = pk2(v1[0], v1[1]); w.w = pk2(v1[2], v1[3]);
                        *(u32x4*)(obase + row * ldo + col) = w;
                    } } }
            if (MODE == 1 || MODE == 2 || MODE == 3 || MODE == 5 || MODE == 6) __builtin_amdgcn_sched_barrier(0); }
    }
};

struct EpiDual {
    static constexpr bool PERM = true, AFTER_DRAIN = false, DUAL = true, MUT = false;
    bf16* mg; const bf16* sga; const bf16* sgb;
    __device__ __forceinline__ void dual(f32x4 (&acc)[2][2][4][2], const pg8::Unit& u, int wr, int wc, int fr, int fq) const {
        const int row0 = u.pm * 256 + wr * 64 + fr, col0 = u.pn * 256 + wc * 32 + 8 * fq; const bool first = (u.z == 0);
#pragma unroll
        for (int aq = 0; aq < 4; ++aq) { const int ai = aq >> 1, mh = aq & 1;
            u32x4 ga[2][2], gbv[2][2];
#pragma unroll
            for (int m2 = 0; m2 < 2; ++m2) { const size_t row = (size_t)(row0 + ai * 128 + (2 * mh + m2) * 16);
#pragma unroll
                for (int bj = 0; bj < 2; ++bj) { const int col = col0 + bj * 128; gbv[m2][bj] = *(const u32x4*)(sgb + row * 2048 + col); if (first) ga[m2][bj] = *(const u32x4*)(sga + row * 2048 + col); else ga[m2][bj] = (u32x4){0u, 0u, 0u, 0u}; } }
            __builtin_amdgcn_sched_barrier(0);
#pragma unroll
            for (int m2 = 0; m2 < 2; ++m2) { const int m = 2 * mh + m2; const size_t row = (size_t)(row0 + ai * 128 + m * 16);
#pragma unroll
                for (int bj = 0; bj < 2; ++bj) { const u32x4 gB = gbv[m2][bj], gA = ga[m2][bj]; const int col = col0 + bj * 128;
                    f32x4 b0 = {bflo(gB.x), bfhi(gB.x), bflo(gB.y), bfhi(gB.y)}, b1 = {bflo(gB.z), bfhi(gB.z), bflo(gB.w), bfhi(gB.w)};
#pragma unroll
                    for (int e = 0; e < 4; ++e) { b0[e] = fmaxf(b0[e], 1e-30f); b1[e] = fmaxf(b1[e], 1e-30f); }
                    if (first) {
                        const f32x4 a0 = {bflo(gA.x), bfhi(gA.x), bflo(gA.y), bfhi(gA.y)}, a1 = {bflo(gA.z), bfhi(gA.z), bflo(gA.w), bfhi(gA.w)};
#pragma unroll
                        for (int e = 0; e < 4; ++e) { acc[ai][bj][m][0][e] *= a0[e] / b0[e]; acc[ai][bj][m][1][e] *= a1[e] / b1[e]; }
                    } else {
                        const f32x4 v0 = acc[ai][bj][m][0] * b0, v1 = acc[ai][bj][m][1] * b1;
                        u32x4 w; w.x = pk2(v0[0], v0[1]); w.y = pk2(v0[2], v0[3]); w.z = pk2(v1[0], v1[1]); w.w = pk2(v1[2], v1[3]);
                        *(u32x4*)(mg + row * 2048 + col) = w; } } }
            __builtin_amdgcn_sched_barrier(0); }
    }
    __device__ __forceinline__ void operator()(const f32x4 (&)[2][2][4][2], const pg8::Unit&, int, int, int, int) const {}
};

struct EpiFinal {
    static constexpr bool PERM = true, AFTER_DRAIN = false, DUAL = false, MUT = true;
    float* out; const bf16* x1b; const float* gate; const float* gfin; float* rowss; unsigned* pcnt; LAS float* scr;
    __device__ __forceinline__ void dual(f32x4 (&acc)[2][2][4][2], const pg8::Unit& u, int wr, int wc, int fr, int fq) const {
        const int row0 = u.pm * 256 + wr * 64 + fr, col0 = u.pn * 256 + wc * 32 + 8 * fq, lane = fr + 16 * fq;
        f32x4 g0[2], g1[2];
        { const float* gp = gate + (size_t)((u.pm * 256) / SEQ) * NMOD + col0;
#pragma unroll
          for (int bj = 0; bj < 2; ++bj) { g0[bj] = *(const f32x4*)(gp + bj * 128); g1[bj] = *(const f32x4*)(gp + bj * 128 + 4); } }
        float ssq[2][4];
#pragma unroll
        for (int aq = 0; aq < 4; ++aq) { const int ai = aq >> 1, mh = aq & 1; u32x4 gw[2][2];
#pragma unroll
            for (int m2 = 0; m2 < 2; ++m2)
#pragma unroll
                for (int bj = 0; bj < 2; ++bj) gw[m2][bj] = *(const u32x4*)(x1b + (size_t)(row0 + ai * 128 + (2 * mh + m2) * 16) * 2048 + col0 + bj * 128);
            __builtin_amdgcn_sched_barrier(0);
#pragma unroll
            for (int m2 = 0; m2 < 2; ++m2) { const int m = 2 * mh + m2; float ss = 0.f;
#pragma unroll
                for (int bj = 0; bj < 2; ++bj) { const u32x4 g = gw[m2][bj];
                    const f32x4 x0 = {bflo(g.x), bfhi(g.x), bflo(g.y), bfhi(g.y)}, x1 = {bflo(g.z), bfhi(g.z), bflo(g.w), bfhi(g.w)};
                    const f32x4 v0 = x0 + g0[bj] * acc[ai][bj][m][0], v1 = x1 + g1[bj] * acc[ai][bj][m][1];
                    acc[ai][bj][m][0] = v0; acc[ai][bj][m][1] = v1;
                    ss += (v0[0] * v0[0] + v0[1] * v0[1]) + (v0[2] * v0[2] + v0[3] * v0[3]) + (v1[0] * v1[0] + v1[1] * v1[1]) + (v1[2] * v1[2] + v1[3] * v1[3]); }
                ss += shx(ss, 16, lane); ss += shx(ss, 32, lane); ssq[ai][m] = ss; }
            __builtin_amdgcn_sched_barrier(0); }
        if (fq == 0) {
#pragma unroll
            for (int ai = 0; ai < 2; ++ai)
#pragma unroll
                for (int m = 0; m < 4; ++m) scr[(wr * 64 + ai * 128 + m * 16 + fr) * 4 + wc] = ssq[ai][m]; }
        asm volatile("s_waitcnt lgkmcnt(0)" ::: "memory"); __builtin_amdgcn_s_barrier(); asm volatile("" ::: "memory");
        const int tid = (wr * 4 + wc) * 64 + lane;
        if (tid < 256) { const f32x4 q4 = *(const LAS f32x4*)(scr + tid * 4);
            __hip_atomic_fetch_add(rowss + u.pm * 256 + tid, (q4[0] + q4[1]) + (q4[2] + q4[3]), __ATOMIC_RELAXED, __HIP_MEMORY_SCOPE_AGENT); }
        asm volatile("s_waitcnt vmcnt(0) lgkmcnt(0)" ::: "memory"); __builtin_amdgcn_s_barrier(); asm volatile("" ::: "memory");
        unsigned* pc = pcnt + 64 * u.pm;
        if (tid == 0) __hip_atomic_fetch_add(pc, 1u, __ATOMIC_RELAXED, __HIP_MEMORY_SCOPE_AGENT);
        { unsigned spins = 0; while (__hip_atomic_load(pc, __ATOMIC_RELAXED, __HIP_MEMORY_SCOPE_AGENT) < 8u) { __builtin_amdgcn_s_sleep(2); if (++spins > (1u << 20)) break; } }
        asm volatile("" ::: "memory");
#pragma unroll
        for (int ai = 0; ai < 2; ++ai)
#pragma unroll
            for (int m = 0; m < 4; ++m) { const size_t row = (size_t)(row0 + ai * 128 + m * 16);
                const float tot = __hip_atomic_load(rowss + row, __ATOMIC_RELAXED, __HIP_MEMORY_SCOPE_AGENT);
                const float rstd = rsqrtf(tot * (1.f / DM) + EPS);
#pragma unroll
                for (int bj = 0; bj < 2; ++bj) { const int col = col0 + bj * 128; const f32x4 f0 = *(const f32x4*)(gfin + col), f1 = *(const f32x4*)(gfin + col + 4);
                    float* op = out + row * 2048 + col;
                    *(f32x4*)op = acc[ai][bj][m][0] * rstd * f0; *(f32x4*)(op + 4) = acc[ai][bj][m][1] * rstd * f1; } }
    }
    __device__ __forceinline__ void operator()(const f32x4 (&)[2][2][4][2], const pg8::Unit&, int, int, int, int) const {}
};
__device__ __forceinline__ int my_lane() { int l; asm volatile("v_mbcnt_lo_u32_b32 %0, -1, 0\n\tv_mbcnt_hi_u32_b32 %0, -1, %0" : "=v"(l)); return l; }

__device__ __forceinline__ void tr_item(const float* W, int ldw, int k0, int srccol, bf16* WT, int K, int dstrow0, LAS float* scr, int lane) {
    const int kr = lane >> 4, c4 = lane & 15;
    f32x4 v[16];
#pragma unroll
    for (int i = 0; i < 16; ++i) v[i] = srccol >= 0 ? *(const f32x4*)(W + (size_t)(k0 + kr + 4 * i) * ldw + srccol) : (f32x4){0.f, 0.f, 0.f, 0.f};
#pragma unroll
    for (int i = 0; i < 16; ++i) { LAS float* p = scr + (kr + 4 * i) * 65 + 4 * c4; p[0] = v[i][0]; p[1] = v[i][1]; p[2] = v[i][2]; p[3] = v[i][3]; }
    LDS_WAIT(); asm volatile("" ::: "memory");
    const int c = lane & 7;
#pragma unroll
    for (int j = 0; j < 8; ++j) { const int n = (lane >> 3) + 8 * j; const LAS float* s = scr + (8 * c) * 65 + n;
        u32x4 o; o.x = pk2(s[0 * 65], s[1 * 65]); o.y = pk2(s[2 * 65], s[3 * 65]); o.z = pk2(s[4 * 65], s[5 * 65]); o.w = pk2(s[6 * 65], s[7 * 65]);
        *(u32x4*)(WT + (size_t)(dstrow0 + n) * K + k0 + 8 * c) = o; }
    LDS_WAIT(); asm volatile("" ::: "memory");
}
__device__ __forceinline__ void tr_plain(const float* W, int K, int N, bf16* WT, int item, LAS float* scr, int lane) {
    const int nblk = N / 64, kb = item / nblk, nb = item % nblk;
    tr_item(W, N, 64 * kb, 64 * nb + 4 * (lane & 15), WT, K, 64 * nb, scr, lane);
}
__device__ __forceinline__ void p0_phase(const Args& a, LAS unsigned char* lds, int gw, int NGW, int wave, int lane) {
    LAS float* scr = (LAS float*)(lds + wave * 16896);
    unsigned char* ws = a.ws;
    constexpr int NDB = 193 + 64, I_IN = 32 * NDB, I_SQ = 32 * 32;
    for (int it = gw; it < I_IN + 3 * I_SQ; it += NGW) {
        if (it < I_IN) {
            const int kb = it / NDB, db = it % NDB;
            int dstrow0; bf16* WT;
            if (db < 193) { dstrow0 = 64 * db; WT = (bf16*)(ws + WS_WINLO); } else { dstrow0 = 64 * (db - 193); WT = (bf16*)(ws + WS_WINHI); }
            const int d = (db < 193 ? 64 * db : 12544 + 64 * (db - 193)) + 4 * (lane & 15);
            int src;
            if (d < 6144) src = d; else if (d < 12288) src = d + 16; else if (d < 12304) src = 6144 + (d - 12288); else if (d < 12320) src = d; else if (d < 12544) src = -1; else src = d - 224;
            tr_item(a.in[5], DIN, 64 * kb, src, WT, DM, dstrow0, scr, lane);
        } else {
            int r = it - I_IN;
            if (r < I_SQ) tr_plain(a.in[10], DM, DM, (bf16*)(ws + WS_WA), r, scr, lane);
            else if (r < 2 * I_SQ) tr_plain(a.in[11], DM, DM, (bf16*)(ws + WS_WB), r - I_SQ, scr, lane);
            else tr_plain(a.in[12], DM, DM, (bf16*)(ws + WS_WO), r - 2 * I_SQ, scr, lane);
        }
    }
    { u32x4* z = (u32x4*)(ws + WS_WINLO + (size_t)12352 * DM * 2); const int n16 = 192 * DM * 2 / 16;
      for (int i = gw * 64 + lane; i < n16; i += NGW * 64) z[i] = (u32x4){0u, 0u, 0u, 0u}; }
    const float* c = a.in[1]; const float* wada = a.in[2]; float* modp = (float*)(ws + WS_MODP);
    for (int it = gw; it < 32 * 48; it += NGW) {
        const int kc = it / 48, nb = it % 48, k0 = kc * 64;
#pragma unroll
        for (int b = 0; b < 8; ++b) { const float v = c[b * DM + k0 + lane]; scr[b * 64 + lane] = v * sigmoidf_(v); }
        LDS_WAIT(); asm volatile("" ::: "memory");
        f32x4 acc[8];
#pragma unroll
        for (int b = 0; b < 8; ++b) acc[b] = (f32x4){0.f, 0.f, 0.f, 0.f};
        const float* wp = wada + (size_t)k0 * NMOD + nb * 256 + lane * 4;
#pragma unroll 8
        for (int kk = 0; kk < 64; ++kk) { const f32x4 w = *(const f32x4*)(wp + (size_t)kk * NMOD);
#pragma unroll
            for (int b = 0; b < 8; ++b) acc[b] += w * scr[b * 64 + kk]; }
#pragma unroll
        for (int b = 0; b < 8; ++b) *(f32x4*)(modp + (size_t)(kc * 8 + b) * NMOD + nb * 256 + lane * 4) = acc[b];
        LDS_WAIT(); asm volatile("" ::: "memory");
    }
}

struct RowRegs { f32x4 v[8]; };
__device__ __forceinline__ void row_load(RowRegs& R, const float* xrow, int lane) {
#pragma unroll
    for (int j = 0; j < 8; ++j) R.v[j] = *(const f32x4*)(xrow + (j * 64 + lane) * 4);
}
__device__ __forceinline__ void row_load_b16(RowRegs& R, const bf16* xrow, int lane) {
#pragma unroll
    for (int j = 0; j < 4; ++j) { const u32x4 w = *(const u32x4*)(xrow + (j * 64 + lane) * 8);
        R.v[2 * j] = (f32x4){bflo(w.x), bfhi(w.x), bflo(w.y), bfhi(w.y)}; R.v[2 * j + 1] = (f32x4){bflo(w.z), bfhi(w.z), bflo(w.w), bfhi(w.w)}; }
}
template <bool SRC16> __device__ __forceinline__ int row_col(int j, int lane) { return SRC16 ? ((j >> 1) * 64 + lane) * 8 + (j & 1) * 4 : (j * 64 + lane) * 4; }
template <class SC, bool SRC16 = false>
__device__ __forceinline__ void norm_finish_bf16(const RowRegs& R, const float* g, SC scp, SC shp, bf16* orow, int lane) {
    float ss = 0.f;
#pragma unroll
    for (int j = 0; j < 8; ++j) ss += (R.v[j][0] * R.v[j][0] + R.v[j][1] * R.v[j][1]) + (R.v[j][2] * R.v[j][2] + R.v[j][3] * R.v[j][3]);
    const float rstd = rsqrtf(wave_sum(ss, lane) * (1.f / DM) + EPS);
#pragma unroll
    for (int j = 0; j < 8; ++j) { const int col = row_col<SRC16>(j, lane); const f32x4 gg = *(const f32x4*)(g + col);
        float o[4];
#pragma unroll
        for (int e = 0; e < 4; ++e) o[e] = R.v[j][e] * rstd * gg[e] * (1.f + scp[col + e]) + shp[col + e];
        u32x2 w; w.x = pk2(o[0], o[1]); w.y = pk2(o[2], o[3]); *(u32x2*)(orow + col) = w; }
}
__device__ __forceinline__ void p1_phase(const Args& a, LAS unsigned char* lds, int tid, int wave, int lane) {
    unsigned char* ws = a.ws; const float* modp = (const float*)(ws + WS_MODP); const float* bada = a.in[3]; float* mod = (float*)(ws + WS_MOD);
    const int G = gridDim.x;
    for (int o = blockIdx.x * 512 + tid; o < 8 * NMOD; o += G * 512) { float s = bada[o % NMOD];
#pragma unroll 8
        for (int kc = 0; kc < 32; ++kc) s += modp[(size_t)kc * 8 * NMOD + o];
        mod[o] = s; }
    LAS float* ml = (LAS float*)lds;
    bf16* H = (bf16*)a.out;
    for (int it = blockIdx.x; it < MT / 64; it += G) {
        const int b = it / 32;
        __syncthreads();
        for (int o = tid; o < 4096; o += 512) { float s = bada[o];
#pragma unroll 8
            for (int kc = 0; kc < 32; ++kc) s += modp[(size_t)(kc * 8 + b) * NMOD + o];
            ml[o] = s; }
        __syncthreads();
        for (int r = 0; r < 8; r += 2) { const int row = it * 64 + wave * 8 + r; RowRegs R0, R1;
            row_load(R0, a.in[0] + (size_t)row * DM, lane); row_load(R1, a.in[0] + (size_t)(row + 1) * DM, lane);
            norm_finish_bf16<const LAS float*>(R0, a.in[4], ml + 2048, ml, H + (size_t)row * DM, lane);
            norm_finish_bf16<const LAS float*>(R1, a.in[4], ml + 2048, ml, H + (size_t)(row + 1) * DM, lane); }
        __syncthreads();
        { const int rt = wave >> 1, ct = wave & 1, fr = lane & 15, quad = lane >> 4;
          const bf16* ap = H + (size_t)(it * 64 + rt * 16 + fr) * DM + quad * 8; const bf16* bp = (const bf16*)(ws + WS_WINLO) + (size_t)(12288 + ct * 16 + fr) * DM + quad * 8;
          f32x4 acc0 = {0.f, 0.f, 0.f, 0.f}, acc1 = {0.f, 0.f, 0.f, 0.f};
          for (int k0 = 0; k0 < 64; k0 += 8) { bf16x8 av[8], bv[8];
#pragma unroll
              for (int k = 0; k < 8; ++k) { av[k] = *(const bf16x8*)(ap + (k0 + k) * 32); bv[k] = *(const bf16x8*)(bp + (k0 + k) * 32); }
#pragma unroll
              for (int k = 0; k < 8; k += 2) { acc0 = __builtin_amdgcn_mfma_f32_16x16x32_bf16(av[k], bv[k], acc0, 0, 0, 0); acc1 = __builtin_amdgcn_mfma_f32_16x16x32_bf16(av[k + 1], bv[k + 1], acc1, 0, 0, 0); } }
          acc0 = acc0 + acc1; float* sp = (float*)(ws + WS_SMALL) + (size_t)(it * 64 + rt * 16 + quad * 4) * 32 + ct * 16 + fr;
#pragma unroll
          for (int i = 0; i < 4; ++i) sp[i * 32] = acc0[i]; }
    }
    __syncthreads();
}

#define LBAR() do { asm volatile("s_waitcnt lgkmcnt(0)" ::: "memory"); __builtin_amdgcn_s_barrier(); asm volatile("" ::: "memory"); } while (0)
#define MFMA16(a_, b_, c_) __builtin_amdgcn_mfma_f32_16x16x32_bf16((a_), (b_), (c_), 0, 0, 0)
__device__ __forceinline__ void gla_prep_unit(const Args& a, LAS unsigned char* lds, int unit, int tid) {
    unsigned char* ws = a.ws;
    const int b = unit >> 7, h = (unit >> 5) & 3, c = unit & 31, R0 = b * SEQ + c * 64;
    LAS float* GA = (LAS float*)lds; LAS float* HT = (LAS float*)(lds + 4096); LAS float* BLR = (LAS float*)(lds + 5120);
    const int dk = tid & 255, half = tid >> 8;
    const float* wup = a.in[6]; float wu[16];
#pragma unroll
    for (int r = 0; r < 16; ++r) wu[r] = wup[r * 1024 + h * 256 + dk];
    const float ba = a.in[7][h * 256 + dk];
    bf16* GQ = (bf16*)(ws + WS_GQ); bf16* GK = (bf16*)(ws + WS_GK); const float* SMALL = (const float*)(ws + WS_SMALL);
    __syncthreads();
    { const f32x2 g2 = *(const f32x2*)(SMALL + (size_t)(R0 + (tid >> 3)) * 32 + (tid & 7) * 2); *(LAS f32x2*)(GA + (tid >> 3) * 16 + (tid & 7) * 2) = g2; }
    bf16* qp = GQ + (size_t)(R0 + half * 32) * 1024 + h * 256 + dk; bf16* kp = GK + (size_t)(R0 + half * 32) * 1024 + h * 256 + dk;
    __syncthreads();
    float bc[32]; float run = 0.f;
#pragma unroll
    for (int tt = 0; tt < 32; ++tt) { const int t = half * 32 + tt; float z = ba;
#pragma unroll
        for (int r4 = 0; r4 < 4; ++r4) { const f32x4 g = *(const LAS f32x4*)(GA + t * 16 + r4 * 4); z += g[0] * wu[r4 * 4] + g[1] * wu[r4 * 4 + 1] + g[2] * wu[r4 * 4 + 2] + g[3] * wu[r4 * 4 + 3]; }
        run += logsig(z) * 0.0625f; bc[tt] = run; }
    if (half == 0) HT[dk] = run;
    __syncthreads();
    if (half == 1) { const float add = HT[dk];
#pragma unroll
        for (int tt = 0; tt < 32; ++tt) bc[tt] += add;
        BLR[dk] = bc[31]; ((float*)(ws + WS_EBLG))[(size_t)unit * 256 + dk] = __expf(bc[31]); }
    __syncthreads();
    const float bl = BLR[dk];
    bf16* kdt = (bf16*)(ws + WS_KDTG) + ((size_t)unit * 256 + dk) * 64 + half * 32;
    float qv[32], kv[32];
#pragma unroll
    for (int tt = 0; tt < 32; ++tt) { qv[tt] = bf2f(qp[(size_t)tt * 1024]); kv[tt] = bf2f(kp[(size_t)tt * 1024]); }
    __syncthreads();
    const int dkp = (dk & ~31) | (((dk >> 2) & 3) << 3) | (((dk >> 4) & 1) << 2) | (dk & 3);
    bf16* qw = qp - dk + dkp; bf16* kw = kp - dk + dkp;
#pragma unroll
    for (int t8 = 0; t8 < 4; ++t8) { float kd[8];
#pragma unroll
        for (int e = 0; e < 8; ++e) { const int tt = t8 * 8 + e;
            qw[(size_t)tt * 1024] = (bf16)f2bf(qv[tt] * __expf(bc[tt]) * 0.0625f);
            kw[(size_t)tt * 1024] = (bf16)f2bf(kv[tt] * __expf(-bc[tt]));
            kd[e] = kv[tt] * __expf(bl - bc[tt]); }
        u32x4 w; w.x = pk2(kd[0], kd[1]); w.y = pk2(kd[2], kd[3]); w.z = pk2(kd[4], kd[5]); w.w = pk2(kd[6], kd[7]);
        *(u32x4*)(kdt + t8 * 8) = w; }
}
__device__ __forceinline__ void cum_item(const Args& a, LAS unsigned char* lds, int item, int tid, int wave, int lane) {
    unsigned char* ws = a.ws; const int b = item >> 4, h = item & 15; LAS float* WTOT = (LAS float*)lds; const float* SMALL = (const float*)(ws + WS_SMALL);
    const float bf_ = a.in[9][h]; float p[4]; float run = 0.f;
#pragma unroll
    for (int e = 0; e < 4; ++e) { run += logsig(SMALL[(size_t)(b * SEQ + tid * 4 + e) * 32 + 16 + h] + bf_); p[e] = run; }
    float sc = run;
#pragma unroll
    for (int o = 1; o < 64; o <<= 1) { const float t = __builtin_bit_cast(float, __builtin_amdgcn_ds_bpermute(((lane - o) & 63) << 2, __builtin_bit_cast(int, sc))); if (lane >= o) sc += t; }
    __syncthreads();
    if (lane == 63) WTOT[wave] = sc;
    __syncthreads();
    float off = sc - run;
    for (int w = 0; w < wave; ++w) off += WTOT[w];
    const float NL = -1.4426950408889634f;
    *(f32x4*)((float*)(ws + WS_CUMG) + (size_t)item * SEQ + tid * 4) = (f32x4){(off + p[0]) * NL, (off + p[1]) * NL, (off + p[2]) * NL, (off + p[3]) * NL};
}
__device__ __forceinline__ void gla_item(const Args& a, LAS unsigned char* lds, int item, int tid_in, int wave, int lane_in) {
    unsigned char* ws = a.ws;
    int tid = tid_in; asm volatile("" : "+v"(tid)); const int lane = tid & 63; (void)lane_in;
    const int bh = item >> 3, slice = item & 7, b = bh >> 2, h = bh & 3;
    LAS unsigned char* QD = lds; LAS unsigned char* KI = lds + 33792; LAS unsigned char* KDT = lds + 67584; LAS unsigned char* VT = lds + 104448; LAS unsigned char* AT = lds + 113664;
    LAS float* OP = (LAS float*)(lds + 122880); LAS float* EBL = (LAS float*)(lds + 139264);
    const int fr = lane & 15, quad = lane >> 4;
    const bf16* GQ = (const bf16*)(ws + WS_GQ); const bf16* GK = (const bf16*)(ws + WS_GK); const bf16* GVT = (const bf16*)(ws + WS_GVT);
    const bf16* KDTG = (const bf16*)(ws + WS_KDTG); const float* EBLG = (const float*)(ws + WS_EBLG); bf16* OA = (bf16*)(ws + WS_OA);
    const int hf = wave >> 2, dvt = wave & 3;
    f32x4 st[8];
#pragma unroll
    for (int r = 0; r < 8; ++r) st[r] = (f32x4){0.f, 0.f, 0.f, 0.f};
    const bf16* gq = GQ + (size_t)(b * SEQ + (tid >> 5)) * 1024 + h * 256 + (tid & 31) * 8;
    const bf16* gk = GK + (size_t)(b * SEQ + (tid >> 5)) * 1024 + h * 256 + (tid & 31) * 8;
    const bf16* gd = KDTG + ((size_t)(bh * 32) * 256 + (tid >> 3)) * 64 + (tid & 7) * 8;
    const bf16* gv = GVT + ((size_t)(b * 32) * DM + h * 512 + slice * 64 + (tid >> 3)) * 64 + (tid & 7) * 8;
    const float* ge = EBLG + (size_t)(bh * 32) * 256 + (tid & 255);
    struct PF { u32x4 q[4], k[4], d[4], v; float e; };
    PF pfA;
#define GLA_LOAD(P_, c_) do { _Pragma("unroll") for (int i = 0; i < 4; ++i) { P_.q[i] = *(const u32x4*)(gq + (size_t)((c_) * 64 + i * 16) * 1024); P_.k[i] = *(const u32x4*)(gk + (size_t)((c_) * 64 + i * 16) * 1024); \
        P_.d[i] = *(const u32x4*)(gd + (size_t)(c_) * 256 * 64 + (size_t)i * 64 * 64); } P_.v = *(const u32x4*)(gv + (size_t)(c_) * DM * 64); P_.e = ge[(size_t)(c_) * 256]; } while (0)
#define GLA_STORE(P_) do { _Pragma("unroll") for (int i = 0; i < 4; ++i) { *(LAS u32x4*)(QD + ((tid >> 5) + i * 16) * 528 + (tid & 31) * 16) = P_.q[i]; *(LAS u32x4*)(KI + ((tid >> 5) + i * 16) * 528 + (tid & 31) * 16) = P_.k[i]; \
        *(LAS u32x4*)(KDT + ((tid >> 3) + i * 64) * 144 + (tid & 7) * 16) = P_.d[i]; } *(LAS u32x4*)(VT + (tid >> 3) * 144 + (tid & 7) * 16) = P_.v; if (tid < 256) EBL[tid] = P_.e; } while (0)
    GLA_LOAD(pfA, 0);
    const LAS unsigned char* QDl = QD + fr * 528 + quad * 16; const LAS unsigned char* KIl = KI + fr * 528 + quad * 16;
    const LAS unsigned char* KDl = KDT + (hf * 128 + fr) * 144 + quad * 16; const LAS unsigned char* VTl = VT + (dvt * 16 + fr) * 144 + quad * 16; const LAS unsigned char* ATl = AT + fr * 144 + hf * 64 + quad * 16;
    for (int c = 0; c < 32; ++c) {
        const int R0 = b * SEQ + c * 64;
        LBAR();
        GLA_STORE(pfA); if (c + 1 < 32) GLA_LOAD(pfA, c + 1);
        LBAR();
        { const int tq = wave >> 1, sq0 = 2 * (wave & 1);
          f32x4 acc0 = {0.f, 0.f, 0.f, 0.f}, acc1 = {0.f, 0.f, 0.f, 0.f}, acc2 = {0.f, 0.f, 0.f, 0.f}, acc3 = {0.f, 0.f, 0.f, 0.f};
          if (sq0 <= tq) { bf16x8 qa[8], kb[8];
#pragma unroll
              for (int ks = 0; ks < 8; ++ks) { qa[ks] = *(const LAS bf16x8*)(QDl + tq * 16 * 528 + ks * 64); kb[ks] = *(const LAS bf16x8*)(KIl + sq0 * 16 * 528 + ks * 64); }
              __builtin_amdgcn_sched_barrier(0);
#pragma unroll
              for (int ks = 0; ks < 8; ks += 2) { acc0 = MFMA16(qa[ks], kb[ks], acc0); acc1 = MFMA16(qa[ks + 1], kb[ks + 1], acc1); }
              __builtin_amdgcn_sched_barrier(0);
              if (sq0 + 1 <= tq) {
#pragma unroll
                  for (int ks = 0; ks < 8; ++ks) kb[ks] = *(const LAS bf16x8*)(KIl + (sq0 + 1) * 16 * 528 + ks * 64);
                  __builtin_amdgcn_sched_barrier(0);
#pragma unroll
                  for (int ks = 0; ks < 8; ks += 2) { acc2 = MFMA16(qa[ks], kb[ks], acc2); acc3 = MFMA16(qa[ks + 1], kb[ks + 1], acc3); }
                  __builtin_amdgcn_sched_barrier(0); } }
          acc0 = acc0 + acc1; acc2 = acc2 + acc3;
#pragma unroll
          for (int i = 0; i < 4; ++i) { const int t = tq * 16 + quad * 4 + i, s = sq0 * 16 + fr;
              *(LAS bf16*)(AT + t * 144 + s * 2) = (bf16)f2bf((s <= t) ? acc0[i] : 0.f);
              *(LAS bf16*)(AT + t * 144 + (s + 16) * 2) = (bf16)f2bf((s + 16 <= t) ? acc2[i] : 0.f); } }
        LBAR();
        f32x4 o[4];
        { bf16x8 aa[4], qa[2][4]; const bf16x8 vb = *(const LAS bf16x8*)(VTl + hf * 64);
#pragma unroll
          for (int tq = 0; tq < 4; ++tq) { aa[tq] = *(const LAS bf16x8*)(ATl + tq * 16 * 144); qa[0][tq] = *(const LAS bf16x8*)(QDl + tq * 16 * 528 + hf * 256); }
          __builtin_amdgcn_sched_barrier(0);
#pragma unroll
          for (int tq = 0; tq < 4; ++tq) o[tq] = MFMA16(aa[tq], vb, ((f32x4){0.f, 0.f, 0.f, 0.f}));
#pragma unroll
          for (int kk = 0; kk < 4; ++kk) { u32x4 bw; bw.x = pk2(st[2 * kk][0], st[2 * kk][1]); bw.y = pk2(st[2 * kk][2], st[2 * kk][3]); bw.z = pk2(st[2 * kk + 1][0], st[2 * kk + 1][1]); bw.w = pk2(st[2 * kk + 1][2], st[2 * kk + 1][3]);
              const bf16x8 bv = __builtin_bit_cast(bf16x8, bw);
              if (kk < 3) {
#pragma unroll
                  for (int tq = 0; tq < 4; ++tq) qa[(kk + 1) & 1][tq] = *(const LAS bf16x8*)(QDl + tq * 16 * 528 + hf * 256 + (kk + 1) * 64); }
              __builtin_amdgcn_sched_barrier(0);
#pragma unroll
              for (int tq = 0; tq < 4; ++tq) o[tq] = MFMA16(qa[kk & 1][tq], bv, o[tq]);
              __builtin_amdgcn_sched_barrier(0); } }
        if (hf == 1) {
#pragma unroll
            for (int tq = 0; tq < 4; ++tq)
#pragma unroll
                for (int i = 0; i < 4; ++i) OP[(tq * 16 + quad * 4 + i) * 64 + dvt * 16 + fr] = o[tq][i]; }
        { bf16x8 ka[2][4]; const bf16x8 v0 = *(const LAS bf16x8*)VTl, v1 = *(const LAS bf16x8*)(VTl + 64); f32x4 e4[8];
#pragma unroll
          for (int rt = 0; rt < 8; ++rt) e4[rt] = *(const LAS f32x4*)(EBL + hf * 128 + rt * 16 + quad * 4);
#pragma unroll
          for (int r2 = 0; r2 < 2; ++r2) { ka[0][2 * r2] = *(const LAS bf16x8*)(KDl + r2 * 16 * 144); ka[0][2 * r2 + 1] = *(const LAS bf16x8*)(KDl + r2 * 16 * 144 + 64); }
          __builtin_amdgcn_sched_barrier(0);
#pragma unroll
          for (int rp = 0; rp < 4; ++rp) {
              if (rp < 3) {
#pragma unroll
                  for (int r2 = 0; r2 < 2; ++r2) { ka[(rp + 1) & 1][2 * r2] = *(const LAS bf16x8*)(KDl + (2 * rp + 2 + r2) * 16 * 144); ka[(rp + 1) & 1][2 * r2 + 1] = *(const LAS bf16x8*)(KDl + (2 * rp + 2 + r2) * 16 * 144 + 64); } }
              st[2 * rp] = st[2 * rp] * e4[2 * rp]; st[2 * rp + 1] = st[2 * rp + 1] * e4[2 * rp + 1];
              __builtin_amdgcn_sched_barrier(0);
              st[2 * rp] = MFMA16(ka[rp & 1][0], v0, st[2 * rp]); st[2 * rp + 1] = MFMA16(ka[rp & 1][2], v0, st[2 * rp + 1]);
              st[2 * rp] = MFMA16(ka[rp & 1][1], v1, st[2 * rp]); st[2 * rp + 1] = MFMA16(ka[rp & 1][3], v1, st[2 * rp + 1]);
              __builtin_amdgcn_sched_barrier(0); } }
        LBAR();
        if (hf == 0) { float opv[16];
#pragma unroll
            for (int tq = 0; tq < 4; ++tq)
#pragma unroll
                for (int i = 0; i < 4; ++i) opv[tq * 4 + i] = OP[(tq * 16 + quad * 4 + i) * 64 + dvt * 16 + fr];
            __builtin_amdgcn_sched_barrier(0);
            bf16* oa = OA + (size_t)(R0 + quad * 4) * DM + h * 512 + slice * 64 + dvt * 16 + fr;
#pragma unroll
            for (int tq = 0; tq < 4; ++tq)
#pragma unroll
                for (int i = 0; i < 4; ++i) oa[(size_t)(tq * 16 + i) * DM] = (bf16)f2bf(o[tq][i] + opv[tq * 4 + i]); }
    }
#undef GLA_LOAD
#undef GLA_STORE
    __syncthreads();
}

#define FOX_DMA(jj_, st_) do { _Pragma("unroll") for (int i_ = 0; i_ < 2; ++i_) { \
        __builtin_amdgcn_global_load_lds((const unsigned*)(kgp[i_] + (size_t)(jj_) * 64 * DM), (LAS unsigned*)(lds + (st_) * 32768 + (wave * 2 + i_) * 1024), 16, 0, 0); \
        __builtin_amdgcn_global_load_lds((const unsigned*)(vgp[i_] + (size_t)(jj_) * DM * 64), (LAS unsigned*)(lds + (st_) * 32768 + 16384 + (wave * 2 + i_) * 1024), 16, 0, 0); } } while (0)
template <int ST>
__device__ __forceinline__ void fox_tile(LAS unsigned char* lds, const LAS float* CUM, int wave, int lane, int fr, int quad, int j, int ntile, int q0,
                                         const bf16* const (&kgp)[2], const bf16* const (&vgp)[2], const unsigned (&kro)[4], const unsigned (&vro)[2],
                                         const bf16x8 (&qf)[2][4], f32x4 (&o)[2][8], float (&mrun)[2], float (&lrun)[2]) {
    const float SCL = 0.08838834764831845f * 1.4426950408889634f;
    if (j + 1 < ntile) FOX_DMA(j + 1, ST ^ 1);
    if (j * 64 <= q0 + 31) {
    const LAS unsigned char* KTs = lds + ST * 32768; const LAS unsigned char* VTs = lds + ST * 32768 + 16384;
    f32x4 s[2][4]; bf16x8 kf[4];
#define KFRAG(i_) (*(const LAS bf16x8*)(KTs + ((i_) >> 2) * 4096 + kro[(i_) & 3]))
    kf[0] = KFRAG(0); kf[1] = KFRAG(1); kf[2] = KFRAG(2);
#pragma unroll
    for (int mt = 0; mt < 4; ++mt) { s[0][mt] = (f32x4){0.f, 0.f, 0.f, 0.f}; s[1][mt] = (f32x4){0.f, 0.f, 0.f, 0.f}; }
#pragma unroll
    for (int i = 0; i < 16; ++i) {
        if (i + 3 < 16) kf[(i + 3) & 3] = KFRAG(i + 3);
        __builtin_amdgcn_sched_barrier(0);
        s[0][i >> 2] = MFMA16(kf[i & 3], qf[0][i & 3], s[0][i >> 2]); s[1][i >> 2] = MFMA16(kf[i & 3], qf[1][i & 3], s[1][i >> 2]);
        __builtin_amdgcn_sched_barrier(0); }
#undef KFRAG
    bf16x8 vf[3];
#define VFRAG(i_) (*(const LAS bf16x8*)(VTs + ((i_) >> 1) * 2048 + vro[(i_) & 1]))
    vf[0] = VFRAG(0); vf[1] = VFRAG(1);
    const bool diag = (j * 64 + 63 > q0);
    bf16x8 pb[2][2];
#pragma unroll
    for (int sub = 0; sub < 2; ++sub) { const int q = q0 + sub * 16 + fr; float mx = -__builtin_inff();
#pragma unroll
        for (int mt = 0; mt < 4; ++mt) { const f32x4 ck = *(const LAS f32x4*)(CUM + j * 64 + mt * 16 + quad * 4);
#pragma unroll
            for (int i = 0; i < 4; ++i) { float v = fmaf(s[sub][mt][i], SCL, ck[i]);
                if (diag && (j * 64 + mt * 16 + quad * 4 + i > q)) v = -__builtin_inff();
                s[sub][mt][i] = v; mx = fmaxf(mx, v); } }
        mx = fmaxf(mx, shx(mx, 16, lane)); mx = fmaxf(mx, shx(mx, 32, lane));
        if (!__all(mx - mrun[sub] <= 8.f)) {
            const float mn = fmaxf(mrun[sub], mx), alpha = __builtin_amdgcn_exp2f(mrun[sub] - mn); mrun[sub] = mn; lrun[sub] *= alpha;
#pragma unroll
            for (int d = 0; d < 8; ++d) o[sub][d] = o[sub][d] * alpha; }
        const float mn = mrun[sub]; float ps = 0.f;
#pragma unroll
        for (int mt = 0; mt < 4; ++mt)
#pragma unroll
            for (int i = 0; i < 4; ++i) { const float p = __builtin_amdgcn_exp2f(s[sub][mt][i] - mn); s[sub][mt][i] = p; ps += p; }
        lrun[sub] += ps;
#pragma unroll
        for (int k2 = 0; k2 < 2; ++k2) { u32x4 w; w.x = pk2(s[sub][2 * k2][0], s[sub][2 * k2][1]); w.y = pk2(s[sub][2 * k2][2], s[sub][2 * k2][3]);
            w.z = pk2(s[sub][2 * k2 + 1][0], s[sub][2 * k2 + 1][1]); w.w = pk2(s[sub][2 * k2 + 1][2], s[sub][2 * k2 + 1][3]); pb[sub][k2] = __builtin_bit_cast(bf16x8, w); } }
    __builtin_amdgcn_sched_barrier(0);
#pragma unroll
    for (int i = 0; i < 16; ++i) {
        if (i + 2 < 16) vf[(i + 2) % 3] = VFRAG(i + 2);
        __builtin_amdgcn_sched_barrier(0);
        o[0][i >> 1] = MFMA16(vf[i % 3], pb[0][i & 1], o[0][i >> 1]); o[1][i >> 1] = MFMA16(vf[i % 3], pb[1][i & 1], o[1][i >> 1]);
        __builtin_amdgcn_sched_barrier(0); }
#undef VFRAG
    }
    asm volatile("s_waitcnt vmcnt(0)" ::: "memory");
    LBAR();
}
__device__ __forceinline__ void fox_item(const Args& a, LAS unsigned char* lds, int item, int tid_in, int wave, int lane_in) {
    unsigned char* ws = a.ws;
    int tid = tid_in; asm volatile("" : "+v"(tid)); (void)lane_in;
    const int bh = item >> 2, x = item & 3, b = bh >> 4, h = bh & 15;
    LAS float* CUM = (LAS float*)(lds + 65536);
    const bf16* FQ = (const bf16*)(ws + WS_FQ); const bf16* FK = (const bf16*)(ws + WS_FK); const bf16* FVT = (const bf16*)(ws + WS_FVT);
    bf16* OB = (bf16*)((unsigned char*)a.out + 64 * MiB);
    __syncthreads();
    *(LAS f32x4*)(CUM + tid * 4) = *(const f32x4*)((const float*)(ws + WS_CUMG) + (size_t)bh * SEQ + tid * 4);
    __syncthreads();
    for (int pass = 0; pass < 2; ++pass) {
        const int lane = my_lane(), fr = lane & 15, quad = lane >> 4;
        const int qb = pass ? 7 - x : x, ntile = (qb + 1) * 4, q0 = qb * 256 + wave * 32;
        bf16x8 qf[2][4]; float mrun[2], lrun[2]; f32x4 o[2][8];
#pragma unroll
        for (int sub = 0; sub < 2; ++sub) { const int q = q0 + sub * 16 + fr; mrun[sub] = -1e30f; lrun[sub] = 0.f;
#pragma unroll
            for (int ks = 0; ks < 4; ++ks) qf[sub][ks] = *(const bf16x8*)(FQ + (size_t)(b * SEQ + q) * DM + h * 128 + ks * 32 + quad * 8);
#pragma unroll
            for (int d = 0; d < 8; ++d) o[sub][d] = (f32x4){0.f, 0.f, 0.f, 0.f}; }
        const bf16* kgp[2]; const bf16* vgp[2];
#pragma unroll
        for (int i = 0; i < 2; ++i) { const int L = (wave * 2 + i) * 64 + lane;
            { const int row = L >> 4, c = (L & 15) ^ (row & 15); kgp[i] = FK + (size_t)(b * SEQ + row) * DM + h * 128 + c * 8; }
            { const int row = L >> 3, c = (L & 7) ^ ((row >> 1) & 7); vgp[i] = FVT + ((size_t)(b * 32) * DM + h * 128 + row) * 64 + c * 8; } }
        unsigned kro[4], vro[2];
#pragma unroll
        for (int ks = 0; ks < 4; ++ks) kro[ks] = (unsigned)(fr * 256 + (((ks * 4 + quad) ^ fr) << 4));
#pragma unroll
        for (int k2 = 0; k2 < 2; ++k2) vro[k2] = (unsigned)(fr * 128 + (((k2 * 4 + quad) ^ ((fr >> 1) & 7)) << 4));
        FOX_DMA(0, 0);
        asm volatile("s_waitcnt vmcnt(0)" ::: "memory");
        LBAR();
        for (int j = 0; j < ntile; j += 2) {
            fox_tile<0>(lds, CUM, wave, lane, fr, quad, j, ntile, q0, kgp, vgp, kro, vro, qf, o, mrun, lrun);
            fox_tile<1>(lds, CUM, wave, lane, fr, quad, j + 1, ntile, q0, kgp, vgp, kro, vro, qf, o, mrun, lrun);
        }
#pragma unroll
        for (int sub = 0; sub < 2; ++sub) { float lt = lrun[sub]; lt += shx(lt, 16, lane); lt += shx(lt, 32, lane); const float inv = 1.f / lt; bf16* op = OB + (size_t)(b * SEQ + q0 + sub * 16 + fr) * DM + h * 128 + quad * 4;
#pragma unroll
            for (int d = 0; d < 8; ++d) { u32x2 w; w.x = pk2(o[sub][d][0] * inv, o[sub][d][1] * inv); w.y = pk2(o[sub][d][2] * inv, o[sub][d][3] * inv); *(u32x2*)(op + d * 16) = w; } }
    }
    __syncthreads();
}
#undef FOX_DMA

__device__ __forceinline__ void fix_row(const Args& a, int row, int lane) {
    unsigned char* ws = a.ws; bf16* OA = (bf16*)(ws + WS_OA) + (size_t)row * DM; const bf16* GG = (const bf16*)(ws + WS_GG) + (size_t)row * DM;
    const f32x4 g0 = *(const f32x4*)(a.in[8] + lane * 8), g1 = *(const f32x4*)(a.in[8] + lane * 8 + 4);
#pragma unroll
    for (int hh = 0; hh < 4; ++hh) { const u32x4 w = *(const u32x4*)(OA + hh * 512 + lane * 8); const u32x4 gw = *(const u32x4*)(GG + hh * 512 + lane * 8);
        float v[8] = {bflo(w.x), bfhi(w.x), bflo(w.y), bfhi(w.y), bflo(w.z), bfhi(w.z), bflo(w.w), bfhi(w.w)};
        float gv[8] = {bflo(gw.x), bfhi(gw.x), bflo(gw.y), bfhi(gw.y), bflo(gw.z), bfhi(gw.z), bflo(gw.w), bfhi(gw.w)};
        float ss = 0.f;
#pragma unroll
        for (int e = 0; e < 8; ++e) ss += v[e] * v[e];
        const float rstd = rsqrtf(wave_sum(ss, lane) * (1.f / 512.f) + EPS);
        float r[8];
#pragma unroll
        for (int e = 0; e < 8; ++e) { const float gl = e < 4 ? g0[e] : g1[e - 4]; r[e] = v[e] * rstd * gl * (gv[e] * sigmoidf_(gv[e])); }
        u32x4 ow; ow.x = pk2(r[0], r[1]); ow.y = pk2(r[2], r[3]); ow.z = pk2(r[4], r[5]); ow.w = pk2(r[6], r[7]);
        *(u32x4*)(OA + hh * 512 + lane * 8) = ow; }
}
__device__ __forceinline__ void final_finish(const RowRegs& R, float* orow, const float* g, int lane) {
    float ss = 0.f;
#pragma unroll
    for (int j = 0; j < 8; ++j) ss += (R.v[j][0] * R.v[j][0] + R.v[j][1] * R.v[j][1]) + (R.v[j][2] * R.v[j][2] + R.v[j][3] * R.v[j][3]);
    const float rstd = rsqrtf(wave_sum(ss, lane) * (1.f / DM) + EPS);
#pragma unroll
    for (int j = 0; j < 8; ++j) { const int col = row_col<true>(j, lane); const f32x4 gg = *(const f32x4*)(g + col); *(f32x4*)(orow + col) = R.v[j] * rstd * gg; }
}

#define XB_TMO      128
#define XB_XCNT(j)  (256  + 64 * (j))
#define XB_XSUB(j)  (1280 + 64 * (j))
#define XB_XGEN(j)  (2304 + 64 * (j))
#define XB_TOP      3328
#define XB_TOPGEN   3392
#define XCD_BAR_WORDS 3456
#define XB_SPIN_CAP (1u << 18)

__device__ __forceinline__ unsigned xb_ld(unsigned* p)              { return __hip_atomic_load(p, __ATOMIC_RELAXED, __HIP_MEMORY_SCOPE_AGENT); }
__device__ __forceinline__ unsigned xb_add(unsigned* p, unsigned v) { return __hip_atomic_fetch_add(p, v, __ATOMIC_RELAXED, __HIP_MEMORY_SCOPE_AGENT); }
__device__ __forceinline__ unsigned xb_xcc_id() { return (unsigned)__builtin_amdgcn_s_getreg((3 << 11) | 20) & 0xFu; }
#define XB_SPIN(cond, bar) do { unsigned _sp = 0; while (cond) { __builtin_amdgcn_s_sleep(1); \
    if ((++_sp & 255u) == 0u) { if (xb_ld(&(bar)[XB_TMO])) break; if (_sp > XB_SPIN_CAP) { atomicAdd(&(bar)[XB_TMO], 1u); break; } } } } while (0)

struct XcdBarrier {
    unsigned* bar; unsigned x;
    volatile LAS unsigned* st;
};

__device__ __forceinline__ XcdBarrier xcd_barrier_post(unsigned* bar, volatile LAS unsigned* st, int tid_) {
    XcdBarrier b; b.bar = bar; b.x = xb_xcc_id(); b.st = st;
    if (tid_ == 0) st[2] = xb_add(&bar[XB_XCNT(b.x)], 1u);
    return b;
}
__device__ __forceinline__ void xcd_barrier_complete(unsigned* bar, unsigned x, unsigned& nloc, unsigned& nx) {
    const unsigned G = gridDim.x * gridDim.y * gridDim.z;
    unsigned sum, cnt, mine, sp = 0u;
    for (;;) {
        sum = 0u; cnt = 0u; mine = 0u;
#pragma unroll
        for (unsigned j = 0; j < 16; ++j) { const unsigned c = xb_ld(&bar[XB_XCNT(j)]); sum += c; cnt += (c > 0u) ? 1u : 0u; mine = (j == x) ? c : mine; }
        if (sum == G) break;
        __builtin_amdgcn_s_sleep(1);
        if ((++sp & 255u) == 0u) { if (xb_ld(&bar[XB_TMO])) break; if (sp > XB_SPIN_CAP) { atomicAdd(&bar[XB_TMO], 1u); break; } }
    }
    nloc = mine > 0u ? mine : 1u; nx = cnt > 0u ? cnt : 1u;
}

__device__ __forceinline__ void xcd_barrier(const XcdBarrier& b, int tid_) {
    asm volatile("s_waitcnt vmcnt(0)" ::: "memory");
    __syncthreads();
    if (tid_ == 0) {
        unsigned* bar = b.bar;
        __builtin_amdgcn_s_waitcnt(0);
        unsigned nloc = b.st[0], nx = b.st[1];
        if (nloc == 0u) { xcd_barrier_complete(bar, b.x, nloc, nx); b.st[0] = nloc; b.st[1] = nx; }
        const unsigned old = xb_add(&bar[XB_XSUB(b.x)], 1u);
        const unsigned gen = old / nloc;
        if (old + 1u == (gen + 1u) * nloc) {
            __builtin_amdgcn_fence(__ATOMIC_RELEASE, "agent");
            asm volatile("s_waitcnt vmcnt(0)" ::: "memory");
            const unsigned og = xb_add(&bar[XB_TOP], 1u);
            const unsigned tg = og / nx;
            if (og + 1u == (tg + 1u) * nx) xb_add(&bar[XB_TOPGEN], 1u);
            else XB_SPIN(xb_ld(&bar[XB_TOPGEN]) == tg, bar);
            __builtin_amdgcn_fence(__ATOMIC_ACQUIRE, "agent");
            xb_add(&bar[XB_XGEN(b.x)], 1u);
            asm volatile("s_waitcnt vmcnt(0)" ::: "memory");
        } else {
            XB_SPIN(xb_ld(&bar[XB_XGEN(b.x)]) == gen, bar);
            __builtin_amdgcn_fence(__ATOMIC_ACQUIRE, "agent");
            asm volatile("s_waitcnt vmcnt(0)" ::: "memory");
        }
    }
    __syncthreads();
}

#define WGM_G1A 4
#define WGM_G1B 4
#define WGM_DUAL 4
#define WGM_G3 4
#define WGM_G4 4
#define WGM_G5 4
#define REP_P0 1
#define REP_G1A 1
#define REP_GLA 1
#define REP_FOX 1
#define REP_G4 1
#define REP_G3 1
#define REP_P1 1
#define REP_P7 1
#define REP_G1B 1
#define REP_G2A 1
#define REP_G2B 1
__global__ void __launch_bounds__(512, 2) hybrid_fwd(Args a) {
    extern __shared__ __attribute__((aligned(16))) unsigned char lds_raw[];
    LAS unsigned char* lds = (LAS unsigned char*)lds_raw;
    cg::grid_group grid = cg::this_grid();
    const int G = gridDim.x, NGW = G * 8;
    const int wave0 = __builtin_amdgcn_readfirstlane((int)(threadIdx.x >> 6));
#define MYTID() (wave0 * 64 + my_lane())
    unsigned* barw = (unsigned*)(a.ws + WS_CTL);
    volatile LAS unsigned* MISC = (volatile LAS unsigned*)(lds + LDS_BYTES - 64);
    { const int t0 = MYTID(); if (t0 < 16) MISC[t0] = 0u;
      if (blockIdx.x == 0) for (int i = t0; i < XCD_BAR_WORDS; i += 512) barw[i] = 0u; }
    __syncthreads();
#define FRESH() int tid = MYTID(); asm volatile("" : "+v"(tid)); const int lane = tid & 63, wave = __builtin_amdgcn_readfirstlane(tid >> 6), gw = blockIdx.x * 8 + wave; (void)lane; (void)gw
    unsigned char* ws = a.ws;
    const float* MOD = (const float*)(ws + WS_MOD);

    for (int rep = 0; rep < REP_P0; ++rep) { FRESH(); p0_phase(a, lds, gw, NGW, wave, lane); __syncthreads(); }
    grid.sync();
    const XcdBarrier xbar = xcd_barrier_post(barw, MISC, MYTID());
#define GRID_BAR() do { unsigned long long bp_ = (unsigned long long)(a.ws + WS_CTL); asm volatile("" : "+s"(bp_)); XcdBarrier xb_ = xbar; xb_.bar = (unsigned*)bp_; xcd_barrier(xb_, MYTID()); } while (0)
    for (int rep = 0; rep < REP_P1; ++rep) { FRESH(); p1_phase(a, lds, tid, wave, lane); }
    GRID_BAR();
    for (int rep = 0; rep < REP_G1A; ++rep) {
        pg8::Gemm g{(const bf16*)a.out, (const bf16*)(ws + WS_WINLO), MT, N1A, DM, nullptr, nullptr}; pg8::StaticOrder S; S.init(MT, N1A, G, (int)blockIdx.x, WGM_G1A);
        EpiProj E{ws};
        pg8::gemm_phase<EpiProj, pg8::StaticOrder, true, true>(lds, g, S, E, MYTID());
    }
    GRID_BAR();
    { FRESH(); for (int it = blockIdx.x; it < 1024; it += G) gla_prep_unit(a, lds, it, tid);
      __syncthreads();
      for (int it = blockIdx.x; it < 128; it += G) cum_item(a, lds, it, tid, wave, lane); }
    GRID_BAR();
    int vb = (int)blockIdx.x;
    if (G == 256) { bool even = true;
        for (unsigned j = 0; j < 8; ++j) even = even && (xb_ld(&barw[XB_XCNT(j)]) == 32u);
        const unsigned xr = MISC[2];
        vb = (even && xbar.x < 8u && xr < 32u) ? (int)(xbar.x * 32u + xr) : (int)((blockIdx.x & 7) * 32 + (blockIdx.x >> 3)); }
    vb = __builtin_amdgcn_readfirstlane(vb);
    for (int rep = 0; rep < REP_GLA; ++rep)
    for (int it = vb; it < 256; it += G) { FRESH(); gla_item(a, lds, it, tid, wave, lane); }
    for (int rep = 0; rep < REP_FOX; ++rep)
    for (int it = vb; it < 512; it += G) { FRESH(); fox_item(a, lds, it, tid, wave, lane); }
    GRID_BAR();
    {
        FRESH();
        for (int row = gw; row < MT; row += NGW) fix_row(a, row, lane);
        LAS float* scr = (LAS float*)(lds + wave * 16896);
        for (int it = gw; it < 32 * 128; it += NGW) tr_plain(a.in[14], DM, DFF, (bf16*)(ws + WS_W1), it, scr, lane);
        __syncthreads();
        pg8::Gemm g{(const bf16*)a.out, (const bf16*)(ws + WS_WINHI), MT, N1B, DM, nullptr, nullptr}; pg8::StaticOrder S; S.init(MT, N1B, G, (int)blockIdx.x, WGM_G1B);
        EpiGen<0> E{(bf16*)(ws + WS_SGA), 2048, nullptr, nullptr, nullptr, nullptr, nullptr};
        for (int rep = 0; rep < REP_G1B; ++rep) pg8::gemm_phase<EpiGen<0>, pg8::StaticOrder, true, true>(lds, g, S, E, MYTID());
    }
    GRID_BAR();
    {
        pg8::DualOrder S; S.init(MT, DM, G, (int)blockIdx.x, WGM_DUAL);
        pg8::Gemm g{(const bf16*)(ws + WS_OA), (const bf16*)(ws + WS_WA), MT, DM, DM, (const bf16*)((unsigned char*)a.out + 64 * MiB), (const bf16*)(ws + WS_WB)};
        EpiDual E{(bf16*)(ws + WS_MG), (const bf16*)(ws + WS_SGA), (const bf16*)(ws + WS_SGB)};
        pg8::gemm_phase<EpiDual, pg8::DualOrder, true, true>(lds, g, S, E, MYTID());
    }
    GRID_BAR();
    for (int rep = 0; rep < REP_G3; ++rep) {
        pg8::Gemm g{(const bf16*)(ws + WS_MG), (const bf16*)(ws + WS_WO), MT, DM, DM, nullptr, nullptr}; pg8::StaticOrder S; S.init(MT, DM, G, (int)blockIdx.x, WGM_G3);
        EpiGen<5> E{(bf16*)(ws + WS_X1B), 2048, nullptr, nullptr, a.in[0], nullptr, MOD + 2 * DM};
        pg8::gemm_phase<EpiGen<5>, pg8::StaticOrder, true, true>(lds, g, S, E, MYTID());
    }
    GRID_BAR();
    for (int rep = 0; rep < REP_P7; ++rep) {
        FRESH();
        bf16* H2 = (bf16*)(ws + WS_H2);
        for (int row = 2 * gw; row < MT; row += 2 * NGW) { const float* mb = MOD + (size_t)(row / SEQ) * NMOD; RowRegs R0, R1;
            row_load_b16(R0, (const bf16*)(ws + WS_X1B) + (size_t)row * DM, lane); row_load_b16(R1, (const bf16*)(ws + WS_X1B) + (size_t)(row + 1) * DM, lane);
            norm_finish_bf16<const float*, true>(R0, a.in[13], mb + 4 * DM, mb + 3 * DM, H2 + (size_t)row * DM, lane);
            norm_finish_bf16<const float*, true>(R1, a.in[13], mb + 4 * DM, mb + 3 * DM, H2 + (size_t)(row + 1) * DM, lane); }
        { unsigned* z = (unsigned*)(ws + WS_ROWSS); for (int i = gw * 64 + lane; i < (196608 - 65536 + 16384) / 4; i += NGW * 64) z[i] = 0u; }
        LAS float* scr = (LAS float*)(lds + wave * 16896);
        for (int it = gw; it < 128 * 32; it += NGW) tr_plain(a.in[15], DFF, DM, (bf16*)(ws + WS_W2), it, scr, lane);
        __syncthreads();
    }
    GRID_BAR();
    for (int rep = 0; rep < REP_G4; ++rep) {
        pg8::Gemm g{(const bf16*)(ws + WS_H2), (const bf16*)(ws + WS_W1), MT, DFF, DM, nullptr, nullptr}; pg8::StaticOrder S; S.init(MT, DFF, G, (int)blockIdx.x, WGM_G4);
        EpiGen<4> E{(bf16*)(ws + WS_U), DFF, nullptr, nullptr, nullptr, nullptr, nullptr};
        pg8::gemm_phase<EpiGen<4>, pg8::StaticOrder, true, true>(lds, g, S, E, MYTID());
    }
    GRID_BAR();
    {
        pg8::Gemm g{(const bf16*)(ws + WS_U), (const bf16*)(ws + WS_W2), MT, DM, DFF, nullptr, nullptr}; pg8::StaticOrder S; S.init(MT, DM, G, (int)blockIdx.x, WGM_G5);
        if (G == 256) {
            EpiFinal E{a.out, (const bf16*)(ws + WS_X1B), MOD + 5 * DM, a.in[16], (float*)(ws + WS_ROWSS), (unsigned*)(ws + WS_PCNT), (LAS float*)(lds + 131072)};
            pg8::gemm_phase<EpiFinal, pg8::StaticOrder, true, true>(lds, g, S, E, MYTID());
        } else {
            EpiGen<6> E{(bf16*)(ws + WS_X2B), 2048, (const bf16*)(ws + WS_X1B), nullptr, nullptr, nullptr, MOD + 5 * DM};
            pg8::gemm_phase<EpiGen<6>, pg8::StaticOrder, true, true>(lds, g, S, E, MYTID());
        }
    }
    if (G != 256) {
        GRID_BAR();
        { FRESH(); for (int row = 2 * gw; row < MT; row += 2 * NGW) { RowRegs R0, R1; const bf16* X2B = (const bf16*)(ws + WS_X2B); row_load_b16(R0, X2B + (size_t)row * DM, lane); row_load_b16(R1, X2B + (size_t)(row + 1) * DM, lane);
            final_finish(R0, a.out + (size_t)row * DM, a.in[16], lane); final_finish(R1, a.out + (size_t)(row + 1) * DM, a.in[16], lane); } }
    }
}

extern "C" void kernel_launch(void* const* d_in, const int* in_sizes, int n_in, void* d_out, int out_size, void* d_ws, size_t ws_size, hipStream_t stream) {
    static int grid = 0;
    if (grid == 0) {
        if (n_in != 17 || out_size != MT * DM || ws_size < WS_END) { fprintf(stderr, "kernel_launch: unexpected shapes (n_in %d out %d ws %zu)\n", n_in, out_size, ws_size); grid = -1; return; }
        int dev = 0, cus = 0, per_cu = 0;
        (void)hipGetDevice(&dev); (void)hipDeviceGetAttribute(&cus, hipDeviceAttributeMultiprocessorCount, dev);
        (void)hipFuncSetAttribute((const void*)hybrid_fwd, hipFuncAttributeMaxDynamicSharedMemorySize, LDS_BYTES);
        (void)hipOccupancyMaxActiveBlocksPerMultiprocessor(&per_cu, (const void*)hybrid_fwd, 512, LDS_BYTES);
        if (per_cu < 1) { fprintf(stderr, "kernel_launch: occupancy query says %d blocks per CU\n", per_cu); per_cu = 1; }
        (void)hipGetLastError();
        grid = cus > 0 ? cus : 256;
    }
    if (grid < 0) return;
    Args a{};
    for (int i = 0; i < 17; ++i) a.in[i] = (const float*)d_in[i];
    a.out = (float*)d_out; a.ws = (unsigned char*)d_ws;
    void* args[] = {&a};
    hipError_t e = hipLaunchCooperativeKernel((const void*)hybrid_fwd, dim3(grid), dim3(512), args, LDS_BYTES, stream);
    if (e != hipSuccess) fprintf(stderr, "cooperative launch failed: %s (grid %d)\n", hipGetErrorString(e), grid);
}
```

```cpp
#include <hip/hip_runtime.h>
#include <hip/hip_cooperative_groups.h>
#include <cstdio>
#include <cstdint>
namespace cg = cooperative_groups;
namespace pg8 {
#define PG8_LAS __attribute__((address_space(3)))
typedef unsigned short bf16_t;
typedef short bf16x8 __attribute__((ext_vector_type(8)));
typedef float f32x4 __attribute__((ext_vector_type(4)));
typedef unsigned u32x4 __attribute__((ext_vector_type(4)));
constexpr int BM = 256, BK = 64, HALF = 128, HTB = HALF * BK * 2  , STAGE_BYTES = 8 * HTB, NXCD = 8, WGM = 4;

__host__ __device__ __forceinline__ int lds_byte(int r, int c) { const int st = (r >> 4) * 2 + (c >> 5), rr = r & 15, cc = c & 31, ob = rr * 64 + cc * 2; return st * 1024 + (ob ^ (((ob >> 9) & 1) << 5)); }
__host__ __device__ __forceinline__ void stage_rc(int b, int& R, int& C) { const int st = b / 1024, sb = b % 1024, swz = sb ^ (((sb >> 9) & 1) << 5); R = (st >> 1) * 16 + swz / 64; C = (st & 1) * 32 + (swz % 64) / 2; }
__host__ __device__ __forceinline__ int perm32(int rho) { const int n = rho >> 4, i = rho & 15; return 8 * (i >> 2) + 4 * n + (i & 3); }

struct Unit { int pm, pn, z; };
struct Gemm { const bf16_t* A; const bf16_t* Bt; int M, N, K; const bf16_t* A2; const bf16_t* Bt2; };

struct StaticOrder {
    int nM, nN, nwg, G, c, wgm;
    __host__ __device__ void init(int M, int N, int G_, int c_, int wgm_ = WGM) { nM = M / BM; nN = N / BM; nwg = nM * nN; G = G_; c = c_; wgm = wgm_; }
    __host__ __device__ bool next(int i, Unit& u) const {
        const long L = (long)i * G + c; if (L >= nwg) return false;
        int wgid = (int)L; { const int q = nwg / NXCD, r = nwg % NXCD, xcd = wgid % NXCD, off = wgid / NXCD; wgid = (xcd < r ? xcd * (q + 1) : r * (q + 1) + (xcd - r) * q) + off; }
        const int nig = wgm * nN, gid = wgid / nig, fm = gid * wgm, gsz = (nM - fm) < wgm ? (nM - fm) : wgm;
        u.pm = fm + ((wgid % nig) % gsz); u.pn = (wgid % nig) / gsz; u.z = 0; return true;
    }
    __device__ __forceinline__ void a_ready(const Unit&) const {}
    __device__ __forceinline__ void done(const Unit&) const {}
};
struct DualOrder {
    StaticOrder base;
    __host__ __device__ void init(int M, int N, int G_, int c_, int wgm_ = WGM) { base.init(M, N, G_, c_, wgm_); }
    __host__ __device__ bool next(int i, Unit& u) const { if (!base.next(i >> 1, u)) return false; u.z = i & 1; return true; }
    __device__ __forceinline__ void a_ready(const Unit&) const {}
    __device__ __forceinline__ void done(const Unit&) const {}
};

__device__ __forceinline__ unsigned cvt_pk_bf16(float lo, float hi) { unsigned r; asm volatile("v_cvt_pk_bf16_f32 %0, %1, %2" : "=v"(r) : "v"(lo), "v"(hi)); return r; }
typedef float f32x2 __attribute__((ext_vector_type(2)));
template <class Epi, class Sched, bool ALIGN_EPI = false, bool SP2 = false>
__device__ __forceinline__ void gemm_phase(PG8_LAS unsigned char* lds, const Gemm g, const Sched& S, const Epi& E, int tid_in) {
    int tid_l = tid_in; asm volatile("" : "+v"(tid_l)); const int tid = tid_l, wid = __builtin_amdgcn_readfirstlane(tid >> 6), lane = tid & 63, wr = wid >> 2, wc = wid & 3, fr = lane & 15, fq = lane >> 4;
    const int K = g.K, nt = K / BK;
    unsigned voffA[2], voffB[2];
#pragma unroll
    for (int i = 0; i < 2; ++i) { int R, C; stage_rc(tid * 16 + i * 8192, R, C); const int Rb = Epi::PERM ? ((R & ~31) + perm32(R & 31)) : R;
        voffA[i] = (unsigned)(R * K + C) * 2u; voffB[i] = (unsigned)(Rb * K + C) * 2u; }
    const size_t kstep = (size_t)(BK * 2);
    const size_t hstep = (size_t)HALF * K * 2;
    const size_t tstep = 2 * hstep;
    const unsigned ldsw = (unsigned)wid * 1024u;
    const int aoff = lds_byte(wr * 64 + fr, fq * 8), boff = lds_byte(wc * 32 + fr, fq * 8);
#define PG8_SA(b, h) (((b) * 2 + (h)) * HTB)
#define PG8_SB(b, h) ((4 + (b) * 2 + (h)) * HTB)
#define PG8_STAGE(bufoff, gbase, voff) do { _Pragma("unroll") for (int _i = 0; _i < 2; ++_i) \
        __builtin_amdgcn_global_load_lds((const unsigned*)((const char*)(gbase) + (voff)[_i]), (PG8_LAS unsigned*)(lds + (bufoff) + ldsw + _i * 8192), 16, 0, 0); } while (0)
#define PG8_LDA(dst, b, h) do { _Pragma("unroll") for (int m = 0; m < 4; ++m) _Pragma("unroll") for (int k = 0; k < 2; ++k) dst[m][k] = *(const PG8_LAS bf16x8*)(lds + PG8_SA(b, h) + aoff + m * 2048 + k * 1024); } while (0)
#define PG8_LDB(dst, b, h) do { _Pragma("unroll") for (int n = 0; n < 2; ++n) _Pragma("unroll") for (int k = 0; k < 2; ++k) dst[n][k] = *(const PG8_LAS bf16x8*)(lds + PG8_SB(b, h) + boff + n * 2048 + k * 1024); } while (0)
#define PG8_MMA(ai, bj, At, Bt) do { __builtin_amdgcn_s_setprio(1); _Pragma("unroll") for (int m = 0; m < 4; ++m) _Pragma("unroll") for (int n = 0; n < 2; ++n) _Pragma("unroll") for (int k = 0; k < 2; ++k) \
        acc[ai][bj][m][n] = __builtin_amdgcn_mfma_f32_16x16x32_bf16(Bt[n][k], At[m][k], acc[ai][bj][m][n], 0, 0, 0); __builtin_amdgcn_s_setprio(0); } while (0)
#define PG8_WAIT_V(n) asm volatile("s_waitcnt vmcnt(" #n ")" ::: "memory")
#define PG8_WAIT_L(n) asm volatile("s_waitcnt lgkmcnt(" #n ")" ::: "memory")
#define PG8_BAR __builtin_amdgcn_s_barrier()
#define PG8_SCHED __builtin_amdgcn_sched_barrier(0)
    Unit cur, nxt; int ui = 0;
    if (!S.next(0, cur)) return;
    f32x4 acc[2][2][4][2];
#pragma unroll
    for (int a = 0; a < 2; ++a)
#pragma unroll
        for (int b = 0; b < 2; ++b)
#pragma unroll
            for (int m = 0; m < 4; ++m)
#pragma unroll
                for (int n = 0; n < 2; ++n) acc[a][b][m][n] = (f32x4){0.f, 0.f, 0.f, 0.f};
    bf16x8 At[4][2], B0[2][2], B1[2][2];
    const char* cA = (const char*)(cur.z ? g.A2 : g.A) + (size_t)cur.pm * tstep; const char* cB = (const char*)(cur.z ? g.Bt2 : g.Bt) + (size_t)cur.pn * tstep;
    S.a_ready(cur);
    if constexpr (SP2) {
        PG8_STAGE(PG8_SB(0, 0), cB, voffB); PG8_STAGE(PG8_SB(0, 1), cB + hstep, voffB); PG8_STAGE(PG8_SA(0, 0), cA, voffA); PG8_STAGE(PG8_SA(0, 1), cA + hstep, voffA);
        if (wr == 1) PG8_BAR;
        PG8_WAIT_V(2); PG8_BAR;
        PG8_STAGE(PG8_SB(1, 0), cB + kstep, voffB); PG8_STAGE(PG8_SA(1, 0), cA + kstep, voffA); PG8_STAGE(PG8_SB(1, 1), cB + hstep + kstep, voffB);
        PG8_WAIT_V(6); PG8_BAR;
    } else {
        PG8_STAGE(PG8_SB(0, 0), cB, voffB); PG8_STAGE(PG8_SA(0, 0), cA, voffA); PG8_STAGE(PG8_SB(0, 1), cB + hstep, voffB); PG8_STAGE(PG8_SA(0, 1), cA + hstep, voffA);
        if (wr == 1) PG8_BAR;
        PG8_WAIT_V(4); PG8_BAR;
        PG8_STAGE(PG8_SB(1, 0), cB + kstep, voffB); PG8_STAGE(PG8_SA(1, 0), cA + kstep, voffA); PG8_STAGE(PG8_SB(1, 1), cB + hstep + kstep, voffB);
        PG8_WAIT_V(6); PG8_BAR;
    }
    for (;;) {
        const bool has_next = S.next(ui + 1, nxt);
        const char* nA = has_next ? (const char*)(nxt.z ? g.A2 : g.A) + (size_t)nxt.pm * tstep : cA; const char* nB = has_next ? (const char*)(nxt.z ? g.Bt2 : g.Bt) + (size_t)nxt.pn * tstep : cB;
        for (int t = 0; t < nt; t += 2) {
            const bool last = (t == nt - 2);
            const char* a1 = cA + (size_t)(t + 1) * kstep;
            const char* a2 = last ? nA : cA + (size_t)(t + 2) * kstep; const char* b2 = last ? nB : cB + (size_t)(t + 2) * kstep;
            const char* a3 = a2 + kstep; const char* b3 = b2 + kstep;
            if (last && has_next) S.a_ready(nxt);
            if constexpr (SP2) {
            PG8_LDB(B0, 0, 0); PG8_LDB(B1, 0, 1); PG8_SCHED; PG8_LDA(At, 0, 0); PG8_STAGE(PG8_SA(1, 1), a1 + hstep, voffA);
            PG8_WAIT_V(8); PG8_WAIT_L(0); PG8_BAR; PG8_MMA(0, 0, At, B0); PG8_MMA(0, 1, At, B1); PG8_BAR; PG8_SCHED;
            PG8_LDA(At, 0, 1); PG8_STAGE(PG8_SB(0, 0), b2, voffB); PG8_STAGE(PG8_SB(0, 1), b2 + hstep, voffB); PG8_STAGE(PG8_SA(0, 0), a2, voffA);
            PG8_WAIT_V(8); PG8_WAIT_L(0); PG8_BAR; PG8_MMA(1, 0, At, B0); PG8_MMA(1, 1, At, B1); PG8_BAR; PG8_SCHED;
            PG8_LDB(B0, 1, 0); PG8_LDB(B1, 1, 1); PG8_SCHED; PG8_LDA(At, 1, 0); PG8_STAGE(PG8_SA(0, 1), a2 + hstep, voffA);
            PG8_WAIT_V(8); PG8_WAIT_L(0); PG8_BAR; PG8_MMA(0, 0, At, B0); PG8_MMA(0, 1, At, B1); PG8_BAR; PG8_SCHED;
            PG8_LDA(At, 1, 1); PG8_STAGE(PG8_SB(1, 0), b3, voffB); PG8_STAGE(PG8_SB(1, 1), b3 + hstep, voffB); PG8_STAGE(PG8_SA(1, 0), a3, voffA);
            PG8_WAIT_V(8); PG8_WAIT_L(0); PG8_BAR; PG8_MMA(1, 0, At, B0); PG8_MMA(1, 1, At, B1); PG8_BAR; PG8_SCHED;
            } else {
            PG8_LDB(B0, 0, 0); PG8_SCHED; PG8_LDA(At, 0, 0); PG8_STAGE(PG8_SA(1, 1), a1 + hstep, voffA);
            PG8_WAIT_L(8); PG8_BAR; PG8_WAIT_L(0); PG8_MMA(0, 0, At, B0); PG8_BAR; PG8_SCHED;
            PG8_LDB(B1, 0, 1); PG8_STAGE(PG8_SB(0, 0), b2, voffB);
            PG8_BAR; PG8_WAIT_L(0); PG8_MMA(0, 1, At, B1); PG8_BAR;
            PG8_LDA(At, 0, 1); PG8_STAGE(PG8_SA(0, 0), a2, voffA);
            PG8_BAR; PG8_WAIT_L(0); PG8_MMA(1, 0, At, B0); PG8_BAR; PG8_SCHED;
            PG8_STAGE(PG8_SB(0, 1), b2 + hstep, voffB);
            PG8_WAIT_V(6); PG8_BAR; PG8_MMA(1, 1, At, B1); PG8_BAR;
            PG8_LDB(B0, 1, 0); PG8_SCHED; PG8_LDA(At, 1, 0); PG8_STAGE(PG8_SA(0, 1), a2 + hstep, voffA);
            PG8_WAIT_L(8); PG8_BAR; PG8_WAIT_L(0); PG8_MMA(0, 0, At, B0); PG8_BAR; PG8_SCHED;
            PG8_LDB(B1, 1, 1); PG8_STAGE(PG8_SB(1, 0), b3, voffB);
            PG8_BAR; PG8_WAIT_L(0); PG8_MMA(0, 1, At, B1); PG8_BAR;
            PG8_LDA(At, 1, 1); PG8_STAGE(PG8_SA(1, 0), a3, voffA);
            PG8_BAR; PG8_WAIT_L(0); PG8_MMA(1, 0, At, B0); PG8_BAR; PG8_SCHED;
            PG8_STAGE(PG8_SB(1, 1), b3 + hstep, voffB);
            PG8_WAIT_V(6); PG8_BAR; PG8_MMA(1, 1, At, B1); PG8_BAR;
            }
        }
        if constexpr (ALIGN_EPI) { if (wr == 0) PG8_BAR; }
        if constexpr (!Epi::AFTER_DRAIN) { if constexpr (Epi::DUAL || Epi::MUT) E.dual(acc, cur, wr, wc, fr, fq); else E(acc, cur, wr, wc, fr, fq); S.done(cur); }
        if (!has_next) break;
        if (!(Epi::DUAL && cur.z == 0))
#pragma unroll
        for (int a = 0; a < 2; ++a)
#pragma unroll
            for (int b = 0; b < 2; ++b)
#pragma unroll
                for (int m = 0; m < 4; ++m)
#pragma unroll
                    for (int n = 0; n < 2; ++n) acc[a][b][m][n] = (f32x4){0.f, 0.f, 0.f, 0.f};
        cur = nxt; cA = nA; cB = nB; ++ui;
        if constexpr (ALIGN_EPI) { if (wr == 1) PG8_BAR; }
    }
    PG8_WAIT_V(0);
    if constexpr (!ALIGN_EPI) { if (wr == 0) PG8_BAR; }
    PG8_BAR;
    if constexpr (Epi::AFTER_DRAIN) { E.fused(acc, cur, wr, wc, fr, fq, lds, wid, lane); S.done(cur); }
#undef PG8_SA
#undef PG8_SB
#undef PG8_STAGE
#undef PG8_LDA
#undef PG8_LDB
#undef PG8_MMA
#undef PG8_WAIT_V
#undef PG8_WAIT_L
#undef PG8_BAR
#undef PG8_SCHED
}
}

#define LAS __attribute__((address_space(3)))
typedef unsigned short bf16;
typedef float f32x4 __attribute__((ext_vector_type(4)));
typedef float f32x2 __attribute__((ext_vector_type(2)));
typedef short bf16x8 __attribute__((ext_vector_type(8)));
typedef short s16x4 __attribute__((ext_vector_type(4)));
typedef unsigned u32x4 __attribute__((ext_vector_type(4)));
typedef unsigned u32x2 __attribute__((ext_vector_type(2)));

constexpr int DM = 2048, NB = 8, SEQ = 2048, MT = NB * SEQ, DIN = 16416, DFF = 8192, NMOD = 6 * DM;
constexpr int N1A = 12288, N1B = 4096;
constexpr float EPS = 1e-6f;
constexpr size_t MiB = 1u << 20;
constexpr size_t WS_MODP = 0, WS_WINLO = 12 * MiB, WS_OA = 0, WS_WINHI = 64 * MiB, WS_MOD = 80 * MiB, WS_SMALL = 81 * MiB, WS_CTL = 83 * MiB, WS_ROWSS = 83 * MiB + 65536, WS_PCNT = 83 * MiB + 196608, WS_ROWSS2 = 83 * MiB + 131072, WS_PCNT2 = 83 * MiB + 212992;
constexpr size_t WS_WA = 84 * MiB, WS_WB = 92 * MiB, WS_WO = 100 * MiB;
constexpr size_t WS_GQ = 108 * MiB, WS_GK = 140 * MiB, WS_GVT = 172 * MiB, WS_GG = 236 * MiB, WS_FQ = 300 * MiB, WS_FK = 364 * MiB, WS_FVT = 428 * MiB, WS_KDTG = 492 * MiB, WS_EBLG = 524 * MiB, WS_CUMG = 525 * MiB, WS_END = 526 * MiB;
constexpr size_t WS_SGA = 108 * MiB, WS_SGB = 300 * MiB, WS_W1 = 172 * MiB, WS_W2 = 204 * MiB, WS_T = 364 * MiB, WS_MG = 236 * MiB, WS_H2 = 108 * MiB, WS_U = 236 * MiB, WS_X2B = 108 * MiB, WS_X1B = 0;
constexpr int LDS_BYTES = 150 * 1024;

struct Args { const float* in[17]; float* out; unsigned char* ws; };

__device__ __forceinline__ unsigned f2bf(float f) { unsigned u = __builtin_bit_cast(unsigned, f); return (u + 0x7fffu + ((u >> 16) & 1u)) >> 16; }
typedef __bf16 bf16x2_t __attribute__((ext_vector_type(2)));
__device__ __forceinline__ unsigned pk2(float lo, float hi) { const f32x2 v = {lo, hi}; const bf16x2_t b = __builtin_convertvector(v, bf16x2_t); return __builtin_bit_cast(unsigned, b); }
__device__ __forceinline__ float bf2f(unsigned short v) { return __builtin_bit_cast(float, (unsigned)v << 16); }
__device__ __forceinline__ float bflo(unsigned w) { return __builtin_bit_cast(float, w << 16); }
__device__ __forceinline__ float bfhi(unsigned w) { return __builtin_bit_cast(float, w & 0xffff0000u); }
__device__ __forceinline__ float shx(float v, int o, int lane) { return __builtin_bit_cast(float, __builtin_amdgcn_ds_bpermute((lane ^ o) << 2, __builtin_bit_cast(int, v))); }
__device__ __forceinline__ float wave_sum(float v, int lane) {
#pragma unroll
    for (int o = 1; o < 64; o <<= 1) v += shx(v, o, lane);
    return v;
}
__device__ __forceinline__ float logsig(float z) { return fminf(z, 0.f) - __logf(1.f + __expf(-fabsf(z))); }
__device__ __forceinline__ float sigmoidf_(float z) { return __builtin_amdgcn_rcpf(1.f + __expf(-z)); }
template <int CTRL> __device__ __forceinline__ unsigned dppu(unsigned x) { return (unsigned)__builtin_amdgcn_mov_dpp((int)x, CTRL, 0xF, 0xF, true); }
template <int CTRL> __device__ __forceinline__ float dppx(float x) { return __builtin_bit_cast(float, __builtin_amdgcn_mov_dpp(__builtin_bit_cast(int, x), CTRL, 0xF, 0xF, true)); }
#define LDS_WAIT() asm volatile("s_waitcnt lgkmcnt(0)" ::: "memory")

struct EpiProj {
    static constexpr bool PERM = true, AFTER_DRAIN = false, DUAL = false, MUT = false;
    unsigned char* ws;
    __device__ __forceinline__ void operator()(const f32x4 (&acc)[2][2][4][2], const pg8::Unit& u, int wr, int wc, int fr, int fq) const {
        const int pn = u.pn, row0 = u.pm * 256 + wr * 64 + fr, cin = wc * 32 + 8 * fq;
        if (pn == 48) {
            if (wc == 0) { float* S = (float*)(ws + WS_SMALL);
#pragma unroll
                for (int ai = 0; ai < 2; ++ai)
#pragma unroll
                    for (int m = 0; m < 4; ++m) { float* p = S + (size_t)(row0 + ai * 128 + m * 16) * 32 + 8 * fq; *(f32x4*)p = acc[ai][0][m][0]; *(f32x4*)(p + 4) = acc[ai][0][m][1]; } }
            return;
        }
        const bool tr = (pn >= 8 && pn < 16) || pn >= 40;
        if (!tr) {
            bf16* base; int ld, c0;
            if (pn < 4) { base = (bf16*)(ws + WS_GQ); ld = 1024; c0 = pn * 256; }
            else if (pn < 8) { base = (bf16*)(ws + WS_GK); ld = 1024; c0 = (pn - 4) * 256; }
            else if (pn < 24) { base = (bf16*)(ws + WS_GG); ld = 2048; c0 = (pn - 16) * 256; }
            else if (pn < 32) { base = (bf16*)(ws + WS_FQ); ld = 2048; c0 = (pn - 24) * 256; }
            else { base = (bf16*)(ws + WS_FK); ld = 2048; c0 = (pn - 32) * 256; }
#pragma unroll
            for (int ai = 0; ai < 2; ++ai)
#pragma unroll
                for (int m = 0; m < 4; ++m) { bf16* rp = base + (size_t)(row0 + ai * 128 + m * 16) * ld + c0 + cin;
#pragma unroll
                    for (int bj = 0; bj < 2; ++bj) { const f32x4 v0 = acc[ai][bj][m][0], v1 = acc[ai][bj][m][1];
                        u32x4 w; w.x = pk2(v0[0], v0[1]); w.y = pk2(v0[2], v0[3]); w.z = pk2(v1[0], v1[1]); w.w = pk2(v1[2], v1[3]);
                        *(u32x4*)(rp + bj * 128) = w; } }
        } else {
            bf16* base = (bf16*)(ws + (pn < 16 ? WS_GVT : WS_FVT)); const int c0 = (pn < 16 ? pn - 8 : pn - 40) * 256;
            const int b = (u.pm * 256) / SEQ, blk0 = ((u.pm * 256) % SEQ) / 64 + wr, jq = fr & 3;
            const bool b0 = (jq & 1) != 0, b1 = (jq & 2) != 0;
            const int sn = 16 * jq + 4 * (fr >> 2); const int s = pn < 16 ? sn : ((sn & ~31) | (((sn >> 2) & 3) << 3) | (((sn >> 4) & 1) << 2));
            bf16* bb = base + (((size_t)b * 32 + blk0) * DM + c0 + cin) * 64 + s;
#pragma unroll
            for (int ai = 0; ai < 2; ++ai)
#pragma unroll
                for (int bj = 0; bj < 2; ++bj)
#pragma unroll
                    for (int n = 0; n < 2; ++n) { unsigned wx[4], wy[4];
#pragma unroll
                        for (int m = 0; m < 4; ++m) { float r0 = acc[ai][bj][m][n][0], r1 = acc[ai][bj][m][n][1], r2 = acc[ai][bj][m][n][2], r3 = acc[ai][bj][m][n][3];
                            { const float x = b0 ? r0 : r1, y = dppx<0xB1>(x); if (b0) r0 = y; else r1 = y; }
                            { const float x = b0 ? r2 : r3, y = dppx<0xB1>(x); if (b0) r2 = y; else r3 = y; }
                            { const float x = b1 ? r0 : r2, y = dppx<0x4E>(x); if (b1) r0 = y; else r2 = y; }
                            { const float x = b1 ? r1 : r3, y = dppx<0x4E>(x); if (b1) r1 = y; else r3 = y; }
                            wx[m] = pk2(r0, r1); wy[m] = pk2(r2, r3); }
                        { const unsigned x = b0 ? wx[0] : wx[1], y = dppu<0xB1>(x); if (b0) wx[0] = y; else wx[1] = y; }
                        { const unsigned x = b0 ? wx[2] : wx[3], y = dppu<0xB1>(x); if (b0) wx[2] = y; else wx[3] = y; }
                        { const unsigned x = b1 ? wx[0] : wx[2], y = dppu<0x4E>(x); if (b1) wx[0] = y; else wx[2] = y; }
                        { const unsigned x = b1 ? wx[1] : wx[3], y = dppu<0x4E>(x); if (b1) wx[1] = y; else wx[3] = y; }
                        { const unsigned x = b0 ? wy[0] : wy[1], y = dppu<0xB1>(x); if (b0) wy[0] = y; else wy[1] = y; }
                        { const unsigned x = b0 ? wy[2] : wy[3], y = dppu<0xB1>(x); if (b0) wy[2] = y; else wy[3] = y; }
                        { const unsigned x = b1 ? wy[0] : wy[2], y = dppu<0x4E>(x); if (b1) wy[0] = y; else wy[2] = y; }
                        { const unsigned x = b1 ? wy[1] : wy[3], y = dppu<0x4E>(x); if (b1) wy[1] = y; else wy[3] = y; }
#pragma unroll
                        for (int mc = 0; mc < 4; ++mc) { u32x2 w; w.x = wx[mc]; w.y = wy[mc];
                            *(u32x2*)(bb + ((size_t)(2 * ai) * DM + bj * 128 + 4 * n + mc) * 64) = w; } }
        }
    }
};
template <int MODE> struct EpiGen {
    static constexpr bool PERM = true, AFTER_DRAIN = false, DUAL = false, MUT = false;
    bf16* ob; int ldo; const bf16* gb; float* tf; const float* xin; float* xout; const float* gate;
    __device__ __forceinline__ void operator()(const f32x4 (&acc)[2][2][4][2], const pg8::Unit& u, int wr, int wc, int fr, int fq) const {
        const int row0 = u.pm * 256 + wr * 64 + fr; int col0 = u.pn * 256 + wc * 32 + 8 * fq;
        bf16* obase = ob;
        if (MODE == 0) { if (u.pn >= 8) { obase = (bf16*)((unsigned char*)ob + (WS_SGB - WS_SGA)); col0 -= 2048; } }
        f32x4 g0[2], g1[2];
        if (MODE == 3 || MODE == 5 || MODE == 6) { const float* gp = gate + (size_t)((u.pm * 256) / SEQ) * NMOD + col0;
#pragma unroll
            for (int bj = 0; bj < 2; ++bj) { g0[bj] = *(const f32x4*)(gp + bj * 128); g1[bj] = *(const f32x4*)(gp + bj * 128 + 4); } }
#pragma unroll
        for (int aq = 0; aq < 4; ++aq) { const int ai = aq >> 1, mh = aq & 1;
            u32x4 gw[2][2]; f32x4 p0[2][2], p1[2][2];
            if (MODE == 1 || MODE == 2 || MODE == 3 || MODE == 5 || MODE == 6) {
#pragma unroll
                for (int m2 = 0; m2 < 2; ++m2) { const size_t row = (size_t)(row0 + ai * 128 + (2 * mh + m2) * 16);
#pragma unroll
                    for (int bj = 0; bj < 2; ++bj) { const int col = col0 + bj * 128;
                        if (MODE == 1 || MODE == 2 || MODE == 6) gw[m2][bj] = *(const u32x4*)(gb + row * 2048 + col);
                        if (MODE == 2) { p0[m2][bj] = *(const f32x4*)(tf + row * 2048 + col); p1[m2][bj] = *(const f32x4*)(tf + row * 2048 + col + 4); }
                        if (MODE == 3 || MODE == 5) { p0[m2][bj] = *(const f32x4*)(xin + row * 2048 + col); p1[m2][bj] = *(const f32x4*)(xin + row * 2048 + col + 4); } } }
                __builtin_amdgcn_sched_barrier(0); }
#pragma unroll
            for (int m2 = 0; m2 < 2; ++m2) { const int m = 2 * mh + m2; const size_t row = (size_t)(row0 + ai * 128 + m * 16);
#pragma unroll
                for (int bj = 0; bj < 2; ++bj) { f32x4 v0 = acc[ai][bj][m][0], v1 = acc[ai][bj][m][1]; const int col = col0 + bj * 128;
                    if (MODE == 0) {
#pragma unroll
                        for (int e = 0; e < 4; ++e) { v0[e] = sigmoidf_(v0[e]); v1[e] = sigmoidf_(v1[e]); }
                        u32x4 w; w.x = pk2(v0[0], v0[1]); w.y = pk2(v0[2], v0[3]); w.z = pk2(v1[0], v1[1]); w.w = pk2(v1[2], v1[3]);
                        *(u32x4*)(obase + row * ldo + col) = w;
                    } else if (MODE == 1 || MODE == 2) {
                        const u32x4 g = gw[m2][bj];
                        const f32x4 s0 = {bflo(g.x), bfhi(g.x), bflo(g.y), bfhi(g.y)}, s1 = {bflo(g.z), bfhi(g.z), bflo(g.w), bfhi(g.w)};
                        float* tp = tf + row * 2048 + col;
                        if (MODE == 1) { *(f32x4*)tp = s0 * v0; *(f32x4*)(tp + 4) = s1 * v1; }
                        else { v0 = p0[m2][bj] + s0 * v0; v1 = p1[m2][bj] + s1 * v1;
                            u32x4 w; w.x = pk2(v0[0], v0[1]); w.y = pk2(v0[2], v0[3]); w.z = pk2(v1[0], v1[1]); w.w = pk2(v1[2], v1[3]);
                            *(u32x4*)(obase + row * ldo + col) = w; }
                    } else if (MODE == 3) {
                        float* op = xout + row * 2048 + col;
                        *(f32x4*)op = p0[m2][bj] + g0[bj] * v0; *(f32x4*)(op + 4) = p1[m2][bj] + g1[bj] * v1;
                    } else if (MODE == 5 || MODE == 6) {
                        f32x4 x0, x1;
                        if (MODE == 5) { x0 = p0[m2][bj]; x1 = p1[m2][bj]; }
                        else { const u32x4 g = gw[m2][bj]; x0 = (f32x4){bflo(g.x), bfhi(g.x), bflo(g.y), bfhi(g.y)}; x1 = (f32x4){bflo(g.z), bfhi(g.z), bflo(g.w), bfhi(g.w)}; }
                        v0 = x0 + g0[bj] * v0; v1 = x1 + g1[bj] * v1;
                        u32x4 w; w.x = pk2(v0[0], v0[1]); w.y = pk2(v0[2], v0[3]); w.z = pk2(v1[0], v1[1]); w.w = pk2(v1[2], v1[3]);
                        *(u32x4*)(obase + row * ldo + col) = w;
                    } else {
#pragma unroll
                        for (int e = 0; e < 4; ++e) { const float a = fmaxf(v0[e], 0.f), c = fmaxf(v1[e], 0.f); v0[e] = a * a; v1[e] = c * c; }
                        u32x4 w; w.x = pk2(v0[0], v0[1]); w.y = pk2(v0[2], v0[3]); w.z = pk2(v1[0], v1[1]); w.w = pk2(v1[2], v1[3]);
                        *(u32x4*)(obase + row * ldo + col) = w;
                    } } }
            if (MODE == 1 || MODE == 2 || MODE == 3 || MODE == 5 || MODE == 6) __builtin_amdgcn_sched_barrier(0); }
    }
};

struct EpiDual {
    static constexpr bool PERM = true, AFTER_DRAIN = false, DUAL = true, MUT = false;
    bf16* mg; const bf16* sga; const bf16* sgb;
    __device__ __forceinline__ void dual(f32x4 (&acc)[2][2][4][2], const pg8::Unit& u, int wr, int wc, int fr, int fq) const {
        const int row0 = u.pm * 256 + wr * 64 + fr, col0 = u.pn * 256 + wc * 32 + 8 * fq; const bool first = (u.z == 0);
#pragma unroll
        for (int aq = 0; aq < 4; ++aq) { const int ai = aq >> 1, mh = aq & 1;
            u32x4 ga[2][2], gbv[2][2];
#pragma unroll
            for (int m2 = 0; m2 < 2; ++m2) { const size_t row = (size_t)(row0 + ai * 128 + (2 * mh + m2) * 16);
#pragma unroll
                for (int bj = 0; bj < 2; ++bj) { const int col = col0 + bj * 128; gbv[m2][bj] = *(const u32x4*)(sgb + row * 2048 + col); if (first) ga[m2][bj] = *(const u32x4*)(sga + row * 2048 + col); else ga[m2][bj] = (u32x4){0u, 0u, 0u, 0u}; } }
            __builtin_amdgcn_sched_barrier(0);
#pragma unroll
            for (int m2 = 0; m2 < 2; ++m2) { const int m = 2 * mh + m2; const size_t row = (size_t)(row0 + ai * 128 + m * 16);
#pragma unroll
                for (int bj = 0; bj < 2; ++bj) { const u32x4 gB = gbv[m2][bj], gA = ga[m2][bj]; const int col = col0 + bj * 128;
                    f32x4 b0 = {bflo(gB.x), bfhi(gB.x), bflo(gB.y), bfhi(gB.y)}, b1 = {bflo(gB.z), bfhi(gB.z), bflo(gB.w), bfhi(gB.w)};
#pragma unroll
                    for (int e = 0; e < 4; ++e) { b0[e] = fmaxf(b0[e], 1e-30f); b1[e] = fmaxf(b1[e], 1e-30f); }
                    if (first) {
                        const f32x4 a0 = {bflo(gA.x), bfhi(gA.x), bflo(gA.y), bfhi(gA.y)}, a1 = {bflo(gA.z), bfhi(gA.z), bflo(gA.w), bfhi(gA.w)};
#pragma unroll
                        for (int e = 0; e < 4; ++e) { acc[ai][bj][m][0][e] *= a0[e] / b0[e]; acc[ai][bj][m][1][e] *= a1[e] / b1[e]; }
                    } else {
                        const f32x4 v0 = acc[ai][bj][m][0] * b0, v1 = acc[ai][bj][m][1] * b1;
                        u32x4 w; w.x = pk2(v0[0], v0[1]); w.y = pk2(v0[2], v0[3]); w.z = pk2(v1[0], v1[1]); w.w = pk2(v1[2], v1[3]);
                        *(u32x4*)(mg + row * 2048 + col) = w; } } }
            __builtin_amdgcn_sched_barrier(0); }
    }
    __device__ __forceinline__ void operator()(const f32x4 (&)[2][2][4][2], const pg8::Unit&, int, int, int, int) const {}
};

struct EpiFinal {
    static constexpr bool PERM = true, AFTER_DRAIN = false, DUAL = false, MUT = true;
    float* out; const bf16* x1b; const float* gate; const float* gfin; float* rowss; unsigned* pcnt; LAS float* scr;
    __device__ __forceinline__ void dual(f32x4 (&acc)[2][2][4][2], const pg8::Unit& u, int wr, int wc, int fr, int fq) const {
        const int row0 = u.pm * 256 + wr * 64 + fr, col0 = u.pn * 256 + wc * 32 + 8 * fq, lane = fr + 16 * fq;
        f32x4 g0[2], g1[2];
        { const float* gp = gate + (size_t)((u.pm * 256) / SEQ) * NMOD + col0;
#pragma unroll
          for (int bj = 0; bj < 2; ++bj) { g0[bj] = *(const f32x4*)(gp + bj * 128); g1[bj] = *(const f32x4*)(gp + bj * 128 + 4); } }
        float ssq[2][4];
#pragma unroll
        for (int aq = 0; aq < 4; ++aq) { const int ai = aq >> 1, mh = aq & 1; u32x4 gw[2][2];
#pragma unroll
            for (int m2 = 0; m2 < 2; ++m2)
#pragma unroll
                for (int bj = 0; bj < 2; ++bj) gw[m2][bj] = *(const u32x4*)(x1b + (size_t)(row0 + ai * 128 + (2 * mh + m2) * 16) * 2048 + col0 + bj * 128);
            __builtin_amdgcn_sched_barrier(0);
#pragma unroll
            for (int m2 = 0; m2 < 2; ++m2) { const int m = 2 * mh + m2; float ss = 0.f;
#pragma unroll
                for (int bj = 0; bj < 2; ++bj) { const u32x4 g = gw[m2][bj];
                    const f32x4 x0 = {bflo(g.x), bfhi(g.x), bflo(g.y), bfhi(g.y)}, x1 = {bflo(g.z), bfhi(g.z), bflo(g.w), bfhi(g.w)};
                    const f32x4 v0 = x0 + g0[bj] * acc[ai][bj][m][0], v1 = x1 + g1[bj] * acc[ai][bj][m][1];
                    acc[ai][bj][m][0] = v0; acc[ai][bj][m][1] = v1;
                    ss += (v0[0] * v0[0] + v0[1] * v0[1]) + (v0[2] * v0[2] + v0[3] * v0[3]) + (v1[0] * v1[0] + v1[1] * v1[1]) + (v1[2] * v1[2] + v1[3] * v1[3]); }
                ss += shx(ss, 16, lane); ss += shx(ss, 32, lane); ssq[ai][m] = ss; }
            __builtin_amdgcn_sched_barrier(0); }
        if (fq == 0) {
#pragma unroll
            for (int ai = 0; ai < 2; ++ai)
#pragma unroll
                for (int m = 0; m < 4; ++m) scr[(wr * 64 + ai * 128 + m * 16 + fr) * 4 + wc] = ssq[ai][m]; }
        asm volatile("s_waitcnt lgkmcnt(0)" ::: "memory"); __builtin_amdgcn_s_barrier(); asm volatile("" ::: "memory");
        const int tid = (wr * 4 + wc) * 64 + lane;
        if (tid < 256) { const f32x4 q4 = *(const LAS f32x4*)(scr + tid * 4);
            __hip_atomic_fetch_add(rowss + u.pm * 256 + tid, (q4[0] + q4[1]) + (q4[2] + q4[3]), __ATOMIC_RELAXED, __HIP_MEMORY_SCOPE_AGENT); }
        asm volatile("s_waitcnt vmcnt(0) lgkmcnt(0)" ::: "memory"); __builtin_amdgcn_s_barrier(); asm volatile("" ::: "memory");
        unsigned* pc = pcnt + 64 * u.pm;
        if (tid == 0) __hip_atomic_fetch_add(pc, 1u, __ATOMIC_RELAXED, __HIP_MEMORY_SCOPE_AGENT);
        { unsigned spins = 0; while (__hip_atomic_load(pc, __ATOMIC_RELAXED, __HIP_MEMORY_SCOPE_AGENT) < 8u) { __builtin_amdgcn_s_sleep(2); if (++spins > (1u << 20)) break; } }
        asm volatile("" ::: "memory");
#pragma unroll
        for (int ai = 0; ai < 2; ++ai)
#pragma unroll
            for (int m = 0; m < 4; ++m) { const size_t row = (size_t)(row0 + ai * 128 + m * 16);
                const float tot = __hip_atomic_load(rowss + row, __ATOMIC_RELAXED, __HIP_MEMORY_SCOPE_AGENT);
                const float rstd = rsqrtf(tot * (1.f / DM) + EPS);
#pragma unroll
                for (int bj = 0; bj < 2; ++bj) { const int col = col0 + bj * 128; const f32x4 f0 = *(const f32x4*)(gfin + col), f1 = *(const f32x4*)(gfin + col + 4);
                    float* op = out + row * 2048 + col;
                    *(f32x4*)op = acc[ai][bj][m][0] * rstd * f0; *(f32x4*)(op + 4) = acc[ai][bj][m][1] * rstd * f1; } }
    }
    __device__ __forceinline__ void operator()(const f32x4 (&)[2][2][4][2], const pg8::Unit&, int, int, int, int) const {}
};
struct EpiMid {
    static constexpr bool PERM = true, AFTER_DRAIN = false, DUAL = false, MUT = true;
    bf16* x1b; bf16* h2; const float* xin; const float* mod; const float* g2; float* rowss; unsigned* pcnt; LAS float* scr;
    __device__ __forceinline__ void dual(f32x4 (&acc)[2][2][4][2], const pg8::Unit& u, int wr, int wc, int fr, int fq) const {
        const int row0 = u.pm * 256 + wr * 64 + fr, col0 = u.pn * 256 + wc * 32 + 8 * fq, lane = fr + 16 * fq;
        const float* mb = mod + (size_t)((u.pm * 256) / SEQ) * NMOD;
        f32x4 g0[2], g1[2];
#pragma unroll
        for (int bj = 0; bj < 2; ++bj) { g0[bj] = *(const f32x4*)(mb + 2 * DM + col0 + bj * 128); g1[bj] = *(const f32x4*)(mb + 2 * DM + col0 + bj * 128 + 4); }
        float ssq[2][4];
#pragma unroll
        for (int aq = 0; aq < 4; ++aq) { const int ai = aq >> 1, mh = aq & 1; f32x4 p0[2][2], p1[2][2];
#pragma unroll
            for (int m2 = 0; m2 < 2; ++m2)
#pragma unroll
                for (int bj = 0; bj < 2; ++bj) { const float* xp = xin + (size_t)(row0 + ai * 128 + (2 * mh + m2) * 16) * 2048 + col0 + bj * 128; p0[m2][bj] = *(const f32x4*)xp; p1[m2][bj] = *(const f32x4*)(xp + 4); }
            __builtin_amdgcn_sched_barrier(0);
#pragma unroll
            for (int m2 = 0; m2 < 2; ++m2) { const int m = 2 * mh + m2; float ss = 0.f; const size_t row = (size_t)(row0 + ai * 128 + m * 16);
#pragma unroll
                for (int bj = 0; bj < 2; ++bj) {
                    const f32x4 v0 = p0[m2][bj] + g0[bj] * acc[ai][bj][m][0], v1 = p1[m2][bj] + g1[bj] * acc[ai][bj][m][1];
                    acc[ai][bj][m][0] = v0; acc[ai][bj][m][1] = v1;
                    ss += (v0[0] * v0[0] + v0[1] * v0[1]) + (v0[2] * v0[2] + v0[3] * v0[3]) + (v1[0] * v1[0] + v1[1] * v1[1]) + (v1[2] * v1[2] + v1[3] * v1[3]);
                    u32x4 w; w.x = pk2(v0[0], v0[1]); w.y = pk2(v0[2], v0[3]); w.z = pk2(v1[0], v1[1]); w.w = pk2(v1[2], v1[3]);
                    *(u32x4*)(x1b + row * 2048 + col0 + bj * 128) = w; }
                ss += shx(ss, 16, lane); ss += shx(ss, 32, lane); ssq[ai][m] = ss; }
            __builtin_amdgcn_sched_barrier(0); }
        if (fq == 0) {
#pragma unroll
            for (int ai = 0; ai < 2; ++ai)
#pragma unroll
                for (int m = 0; m < 4; ++m) scr[(wr * 64 + ai * 128 + m * 16 + fr) * 4 + wc] = ssq[ai][m]; }
        asm volatile("s_waitcnt lgkmcnt(0)" ::: "memory"); __builtin_amdgcn_s_barrier(); asm volatile("" ::: "memory");
        const int tid = (wr * 4 + wc) * 64 + lane;
        if (tid < 256) { const f32x4 q4 = *(const LAS f32x4*)(scr + tid * 4);
            __hip_atomic_fetch_add(rowss + u.pm * 256 + tid, (q4[0] + q4[1]) + (q4[2] + q4[3]), __ATOMIC_RELAXED, __HIP_MEMORY_SCOPE_AGENT); }
        asm volatile("s_waitcnt vmcnt(0) lgkmcnt(0)" ::: "memory"); __builtin_amdgcn_s_barrier(); asm volatile("" ::: "memory");
        unsigned* pc = pcnt + 64 * u.pm;
        if (tid == 0) __hip_atomic_fetch_add(pc, 1u, __ATOMIC_RELAXED, __HIP_MEMORY_SCOPE_AGENT);
        { unsigned spins = 0; while (__hip_atomic_load(pc, __ATOMIC_RELAXED, __HIP_MEMORY_SCOPE_AGENT) < 8u) { __builtin_amdgcn_s_sleep(2); if (++spins > (1u << 20)) break; } }
        asm volatile("" ::: "memory");
        float rs[2][4];
#pragma unroll
        for (int ai = 0; ai < 2; ++ai)
#pragma unroll
            for (int m = 0; m < 4; ++m) rs[ai][m] = rsqrtf(__hip_atomic_load(rowss + row0 + ai * 128 + m * 16, __ATOMIC_RELAXED, __HIP_MEMORY_SCOPE_AGENT) * (1.f / DM) + EPS);
#pragma unroll
        for (int bj = 0; bj < 2; ++bj) { const int col = col0 + bj * 128;
            const f32x4 ga = *(const f32x4*)(g2 + col), gb2 = *(const f32x4*)(g2 + col + 4);
            f32x4 sa = *(const f32x4*)(mb + 4 * DM + col), sb = *(const f32x4*)(mb + 4 * DM + col + 4); const f32x4 ha = *(const f32x4*)(mb + 3 * DM + col), hb = *(const f32x4*)(mb + 3 * DM + col + 4);
            sa = (sa + 1.f) * ga; sb = (sb + 1.f) * gb2;
#pragma unroll
            for (int ai = 0; ai < 2; ++ai)
#pragma unroll
                for (int m = 0; m < 4; ++m) { const size_t row = (size_t)(row0 + ai * 128 + m * 16); const float r = rs[ai][m];
                    const f32x4 o0 = acc[ai][bj][m][0] * r * sa + ha, o1 = acc[ai][bj][m][1] * r * sb + hb;
                    u32x4 w; w.x = pk2(o0[0], o0[1]); w.y = pk2(o0[2], o0[3]); w.z = pk2(o1[0], o1[1]); w.w = pk2(o1[2], o1[3]);
                    *(u32x4*)(h2 + row * 2048 + col) = w; } }
    }
    __device__ __forceinline__ void operator()(const f32x4 (&)[2][2][4][2], const pg8::Unit&, int, int, int, int) const {}
};
__device__ __forceinline__ int my_lane() { int l; asm volatile("v_mbcnt_lo_u32_b32 %0, -1, 0\n\tv_mbcnt_hi_u32_b32 %0, -1, %0" : "=v"(l)); return l; }

__device__ __forceinline__ void tr_item(const float* W, int ldw, int k0, int srccol, bf16* WT, int K, int dstrow0, LAS float* scr, int lane) {
    const int kr = lane >> 4, c4 = lane & 15;
    f32x4 v[16];
#pragma unroll
    for (int i = 0; i < 16; ++i) v[i] = srccol >= 0 ? *(const f32x4*)(W + (size_t)(k0 + kr + 4 * i) * ldw + srccol) : (f32x4){0.f, 0.f, 0.f, 0.f};
#pragma unroll
    for (int i = 0; i < 16; ++i) { LAS float* p = scr + (kr + 4 * i) * 65 + 4 * c4; p[0] = v[i][0]; p[1] = v[i][1]; p[2] = v[i][2]; p[3] = v[i][3]; }
    LDS_WAIT(); asm volatile("" ::: "memory");
    const int c = lane & 7;
#pragma unroll
    for (int j = 0; j < 8; ++j) { const int n = (lane >> 3) + 8 * j; const LAS float* s = scr + (8 * c) * 65 + n;
        u32x4 o; o.x = pk2(s[0 * 65], s[1 * 65]); o.y = pk2(s[2 * 65], s[3 * 65]); o.z = pk2(s[4 * 65], s[5 * 65]); o.w = pk2(s[6 * 65], s[7 * 65]);
        *(u32x4*)(WT + (size_t)(dstrow0 + n) * K + k0 + 8 * c) = o; }
    LDS_WAIT(); asm volatile("" ::: "memory");
}
__device__ __forceinline__ void tr_plain(const float* W, int K, int N, bf16* WT, int item, LAS float* scr, int lane) {
    const int nblk = N / 64, kb = item / nblk, nb = item % nblk;
    tr_item(W, N, 64 * kb, 64 * nb + 4 * (lane & 15), WT, K, 64 * nb, scr, lane);
}
__device__ __forceinline__ void p0_phase(const Args& a, LAS unsigned char* lds, int gw, int NGW, int wave, int lane) {
    LAS float* scr = (LAS float*)(lds + wave * 16896);
    unsigned char* ws = a.ws;
    constexpr int NDB = 193 + 64, I_IN = 32 * NDB, I_SQ = 32 * 32;
    for (int it = gw; it < I_IN + 3 * I_SQ; it += NGW) {
        if (it < I_IN) {
            const int kb = it / NDB, db = it % NDB;
            int dstrow0; bf16* WT;
            if (db < 193) { dstrow0 = 64 * db; WT = (bf16*)(ws + WS_WINLO); } else { dstrow0 = 64 * (db - 193); WT = (bf16*)(ws + WS_WINHI); }
            const int d = (db < 193 ? 64 * db : 12544 + 64 * (db - 193)) + 4 * (lane & 15);
            int src;
            if (d < 6144) src = d; else if (d < 12288) src = d + 16; else if (d < 12304) src = 6144 + (d - 12288); else if (d < 12320) src = d; else if (d < 12544) src = -1; else src = d - 224;
            tr_item(a.in[5], DIN, 64 * kb, src, WT, DM, dstrow0, scr, lane);
        } else {
            int r = it - I_IN;
            if (r < I_SQ) tr_plain(a.in[10], DM, DM, (bf16*)(ws + WS_WA), r, scr, lane);
            else if (r < 2 * I_SQ) tr_plain(a.in[11], DM, DM, (bf16*)(ws + WS_WB), r - I_SQ, scr, lane);
            else tr_plain(a.in[12], DM, DM, (bf16*)(ws + WS_WO), r - 2 * I_SQ, scr, lane);
        }
    }
    { u32x4* z = (u32x4*)(ws + WS_WINLO + (size_t)12352 * DM * 2); const int n16 = 192 * DM * 2 / 16;
      for (int i = gw * 64 + lane; i < n16; i += NGW * 64) z[i] = (u32x4){0u, 0u, 0u, 0u}; }
    const float* c = a.in[1]; const float* wada = a.in[2]; float* modp = (float*)(ws + WS_MODP);
    for (int it = gw; it < 32 * 48; it += NGW) {
        const int kc = it / 48, nb = it % 48, k0 = kc * 64;
#pragma unroll
        for (int b = 0; b < 8; ++b) { const float v = c[b * DM + k0 + lane]; scr[b * 64 + lane] = v * sigmoidf_(v); }
        LDS_WAIT(); asm volatile("" ::: "memory");
        f32x4 acc[8];
#pragma unroll
        for (int b = 0; b < 8; ++b) acc[b] = (f32x4){0.f, 0.f, 0.f, 0.f};
        const float* wp = wada + (size_t)k0 * NMOD + nb * 256 + lane * 4;
#pragma unroll 8
        for (int kk = 0; kk < 64; ++kk) { const f32x4 w = *(const f32x4*)(wp + (size_t)kk * NMOD);
#pragma unroll
            for (int b = 0; b < 8; ++b) acc[b] += w * scr[b * 64 + kk]; }
#pragma unroll
        for (int b = 0; b < 8; ++b) *(f32x4*)(modp + (size_t)(kc * 8 + b) * NMOD + nb * 256 + lane * 4) = acc[b];
        LDS_WAIT(); asm volatile("" ::: "memory");
    }
}

struct RowRegs { f32x4 v[8]; };
__device__ __forceinline__ void row_load(RowRegs& R, const float* xrow, int lane) {
#pragma unroll
    for (int j = 0; j < 8; ++j) R.v[j] = *(const f32x4*)(xrow + (j * 64 + lane) * 4);
}
__device__ __forceinline__ void row_load_b16(RowRegs& R, const bf16* xrow, int lane) {
#pragma unroll
    for (int j = 0; j < 4; ++j) { const u32x4 w = *(const u32x4*)(xrow + (j * 64 + lane) * 8);
        R.v[2 * j] = (f32x4){bflo(w.x), bfhi(w.x), bflo(w.y), bfhi(w.y)}; R.v[2 * j + 1] = (f32x4){bflo(w.z), bfhi(w.z), bflo(w.w), bfhi(w.w)}; }
}
template <bool SRC16> __device__ __forceinline__ int row_col(int j, int lane) { return SRC16 ? ((j >> 1) * 64 + lane) * 8 + (j & 1) * 4 : (j * 64 + lane) * 4; }
template <class SC, bool SRC16 = false>
__device__ __forceinline__ void norm_finish_bf16(const RowRegs& R, const float* g, SC scp, SC shp, bf16* orow, int lane) {
    float ss = 0.f;
#pragma unroll
    for (int j = 0; j < 8; ++j) ss += (R.v[j][0] * R.v[j][0] + R.v[j][1] * R.v[j][1]) + (R.v[j][2] * R.v[j][2] + R.v[j][3] * R.v[j][3]);
    const float rstd = rsqrtf(wave_sum(ss, lane) * (1.f / DM) + EPS);
#pragma unroll
    for (int j = 0; j < 8; ++j) { const int col = row_col<SRC16>(j, lane); const f32x4 gg = *(const f32x4*)(g + col);
        float o[4];
#pragma unroll
        for (int e = 0; e < 4; ++e) o[e] = R.v[j][e] * rstd * gg[e] * (1.f + scp[col + e]) + shp[col + e];
        u32x2 w; w.x = pk2(o[0], o[1]); w.y = pk2(o[2], o[3]); *(u32x2*)(orow + col) = w; }
}
__device__ __forceinline__ void p1_phase(const Args& a, LAS unsigned char* lds, int tid, int wave, int lane) {
    unsigned char* ws = a.ws; const float* modp = (const float*)(ws + WS_MODP); const float* bada = a.in[3]; float* mod = (float*)(ws + WS_MOD);
    const int G = gridDim.x;
    for (int o = blockIdx.x * 512 + tid; o < 8 * NMOD; o += G * 512) { float s = bada[o % NMOD];
#pragma unroll 8
        for (int kc = 0; kc < 32; ++kc) s += modp[(size_t)kc * 8 * NMOD + o];
        mod[o] = s; }
    LAS float* ml = (LAS float*)lds;
    bf16* H = (bf16*)a.out;
    for (int it = blockIdx.x; it < MT / 64; it += G) {
        const int b = it / 32;
        __syncthreads();
        for (int o = tid; o < 4096; o += 512) { float s = bada[o];
#pragma unroll 8
            for (int kc = 0; kc < 32; ++kc) s += modp[(size_t)(kc * 8 + b) * NMOD + o];
            ml[o] = s; }
        __syncthreads();
        for (int r = 0; r < 8; r += 2) { const int row = it * 64 + wave * 8 + r; RowRegs R0, R1;
            row_load(R0, a.in[0] + (size_t)row * DM, lane); row_load(R1, a.in[0] + (size_t)(row + 1) * DM, lane);
            norm_finish_bf16<const LAS float*>(R0, a.in[4], ml + 2048, ml, H + (size_t)row * DM, lane);
            norm_finish_bf16<const LAS float*>(R1, a.in[4], ml + 2048, ml, H + (size_t)(row + 1) * DM, lane); }
        __syncthreads();
        { const int rt = wave >> 1, ct = wave & 1, fr = lane & 15, quad = lane >> 4;
          const bf16* ap = H + (size_t)(it * 64 + rt * 16 + fr) * DM + quad * 8; const bf16* bp = (const bf16*)(ws + WS_WINLO) + (size_t)(12288 + ct * 16 + fr) * DM + quad * 8;
          f32x4 acc0 = {0.f, 0.f, 0.f, 0.f}, acc1 = {0.f, 0.f, 0.f, 0.f};
          for (int k0 = 0; k0 < 64; k0 += 8) { bf16x8 av[8], bv[8];
#pragma unroll
              for (int k = 0; k < 8; ++k) { av[k] = *(const bf16x8*)(ap + (k0 + k) * 32); bv[k] = *(const bf16x8*)(bp + (k0 + k) * 32); }
#pragma unroll
              for (int k = 0; k < 8; k += 2) { acc0 = __builtin_amdgcn_mfma_f32_16x16x32_bf16(av[k], bv[k], acc0, 0, 0, 0); acc1 = __builtin_amdgcn_mfma_f32_16x16x32_bf16(av[k + 1], bv[k + 1], acc1, 0, 0, 0); } }
          acc0 = acc0 + acc1; float* sp = (float*)(ws + WS_SMALL) + (size_t)(it * 64 + rt * 16 + quad * 4) * 32 + ct * 16 + fr;
#pragma unroll
          for (int i = 0; i < 4; ++i) sp[i * 32] = acc0[i]; }
    }
    __syncthreads();
}

#define LBAR() do { asm volatile("s_waitcnt lgkmcnt(0)" ::: "memory"); __builtin_amdgcn_s_barrier(); asm volatile("" ::: "memory"); } while (0)
#define MFMA16(a_, b_, c_) __builtin_amdgcn_mfma_f32_16x16x32_bf16((a_), (b_), (c_), 0, 0, 0)
__device__ __forceinline__ void gla_prep_unit(const Args& a, LAS unsigned char* lds, int unit, int tid) {
    unsigned char* ws = a.ws;
    const int b = unit >> 7, h = (unit >> 5) & 3, c = unit & 31, R0 = b * SEQ + c * 64;
    LAS float* GA = (LAS float*)lds; LAS float* HT = (LAS float*)(lds + 4096); LAS float* BLR = (LAS float*)(lds + 5120);
    const int dk = tid & 255, half = tid >> 8;
    const float* wup = a.in[6]; float wu[16];
#pragma unroll
    for (int r = 0; r < 16; ++r) wu[r] = wup[r * 1024 + h * 256 + dk];
    const float ba = a.in[7][h * 256 + dk];
    bf16* GQ = (bf16*)(ws + WS_GQ); bf16* GK = (bf16*)(ws + WS_GK); const float* SMALL = (const float*)(ws + WS_SMALL);
    __syncthreads();
    { const f32x2 g2 = *(const f32x2*)(SMALL + (size_t)(R0 + (tid >> 3)) * 32 + (tid & 7) * 2); *(LAS f32x2*)(GA + (tid >> 3) * 16 + (tid & 7) * 2) = g2; }
    bf16* qp = GQ + (size_t)(R0 + half * 32) * 1024 + h * 256 + dk; bf16* kp = GK + (size_t)(R0 + half * 32) * 1024 + h * 256 + dk;
    __syncthreads();
    float bc[32]; float run = 0.f;
#pragma unroll
    for (int tt = 0; tt < 32; ++tt) { const int t = half * 32 + tt; float z = ba;
#pragma unroll
        for (int r4 = 0; r4 < 4; ++r4) { const f32x4 g = *(const LAS f32x4*)(GA + t * 16 + r4 * 4); z += g[0] * wu[r4 * 4] + g[1] * wu[r4 * 4 + 1] + g[2] * wu[r4 * 4 + 2] + g[3] * wu[r4 * 4 + 3]; }
        run += logsig(z) * 0.0625f; bc[tt] = run; }
    if (half == 0) HT[dk] = run;
    __syncthreads();
    if (half == 1) { const float add = HT[dk];
#pragma unroll
        for (int tt = 0; tt < 32; ++tt) bc[tt] += add;
        BLR[dk] = bc[31]; ((float*)(ws + WS_EBLG))[(size_t)unit * 256 + dk] = __expf(bc[31]); }
    __syncthreads();
    const float bl = BLR[dk];
    bf16* kdt = (bf16*)(ws + WS_KDTG) + ((size_t)unit * 256 + dk) * 64 + half * 32;
    float qv[32], kv[32];
#pragma unroll
    for (int tt = 0; tt < 32; ++tt) { qv[tt] = bf2f(qp[(size_t)tt * 1024]); kv[tt] = bf2f(kp[(size_t)tt * 1024]); }
    __syncthreads();
    const int dkp = (dk & ~31) | (((dk >> 2) & 3) << 3) | (((dk >> 4) & 1) << 2) | (dk & 3);
    bf16* qw = qp - dk + dkp; bf16* kw = kp - dk + dkp;
#pragma unroll
    for (int t8 = 0; t8 < 4; ++t8) { float kd[8];
#pragma unroll
        for (int e = 0; e < 8; ++e) { const int tt = t8 * 8 + e;
            qw[(size_t)tt * 1024] = (bf16)f2bf(qv[tt] * __expf(bc[tt]) * 0.0625f);
            kw[(size_t)tt * 1024] = (bf16)f2bf(kv[tt] * __expf(-bc[tt]));
            kd[e] = kv[tt] * __expf(bl - bc[tt]); }
        u32x4 w; w.x = pk2(kd[0], kd[1]); w.y = pk2(kd[2], kd[3]); w.z = pk2(kd[4], kd[5]); w.w = pk2(kd[6], kd[7]);
        *(u32x4*)(kdt + t8 * 8) = w; }
}
__device__ __forceinline__ void cum_item(const Args& a, LAS unsigned char* lds, int item, int tid, int wave, int lane) {
    unsigned char* ws = a.ws; const int b = item >> 4, h = item & 15; LAS float* WTOT = (LAS float*)lds; const float* SMALL = (const float*)(ws + WS_SMALL);
    const float bf_ = a.in[9][h]; float p[4]; float run = 0.f;
#pragma unroll
    for (int e = 0; e < 4; ++e) { run += logsig(SMALL[(size_t)(b * SEQ + tid * 4 + e) * 32 + 16 + h] + bf_); p[e] = run; }
    float sc = run;
#pragma unroll
    for (int o = 1; o < 64; o <<= 1) { const float t = __builtin_bit_cast(float, __builtin_amdgcn_ds_bpermute(((lane - o) & 63) << 2, __builtin_bit_cast(int, sc))); if (lane >= o) sc += t; }
    __syncthreads();
    if (lane == 63) WTOT[wave] = sc;
    __syncthreads();
    float off = sc - run;
    for (int w = 0; w < wave; ++w) off += WTOT[w];
    const float NL = -1.4426950408889634f;
    *(f32x4*)((float*)(ws + WS_CUMG) + (size_t)item * SEQ + tid * 4) = (f32x4){(off + p[0]) * NL, (off + p[1]) * NL, (off + p[2]) * NL, (off + p[3]) * NL};
}
__device__ __forceinline__ void gla_item(const Args& a, LAS unsigned char* lds, int item, int tid_in, int wave, int lane_in) {
    unsigned char* ws = a.ws;
    int tid = tid_in; asm volatile("" : "+v"(tid)); const int lane = tid & 63; (void)lane_in;
    const int bh = item >> 3, slice = item & 7, b = bh >> 2, h = bh & 3;
    LAS unsigned char* QD = lds; LAS unsigned char* KI = lds + 33792; LAS unsigned char* KDT = lds + 67584; LAS unsigned char* VT = lds + 104448; LAS unsigned char* AT = lds + 113664;
    LAS float* OP = (LAS float*)(lds + 122880); LAS float* EBL = (LAS float*)(lds + 139264);
    const int fr = lane & 15, quad = lane >> 4;
    const bf16* GQ = (const bf16*)(ws + WS_GQ); const bf16* GK = (const bf16*)(ws + WS_GK); const bf16* GVT = (const bf16*)(ws + WS_GVT);
    const bf16* KDTG = (const bf16*)(ws + WS_KDTG); const float* EBLG = (const float*)(ws + WS_EBLG); bf16* OA = (bf16*)(ws + WS_OA);
    const int hf = wave >> 2, dvt = wave & 3;
    f32x4 st[8];
#pragma unroll
    for (int r = 0; r < 8; ++r) st[r] = (f32x4){0.f, 0.f, 0.f, 0.f};
    const bf16* gq = GQ + (size_t)(b * SEQ + (tid >> 5)) * 1024 + h * 256 + (tid & 31) * 8;
    const bf16* gk = GK + (size_t)(b * SEQ + (tid >> 5)) * 1024 + h * 256 + (tid & 31) * 8;
    const bf16* gd = KDTG + ((size_t)(bh * 32) * 256 + (tid >> 3)) * 64 + (tid & 7) * 8;
    const bf16* gv = GVT + ((size_t)(b * 32) * DM + h * 512 + slice * 64 + (tid >> 3)) * 64 + (tid & 7) * 8;
    const float* ge = EBLG + (size_t)(bh * 32) * 256 + (tid & 255);
    struct PF { u32x4 q[4], k[4], d[4], v; float e; };
    PF pfA;
#define GLA_LOAD(P_, c_) do { _Pragma("unroll") for (int i = 0; i < 4; ++i) { P_.q[i] = *(const u32x4*)(gq + (size_t)((c_) * 64 + i * 16) * 1024); P_.k[i] = *(const u32x4*)(gk + (size_t)((c_) * 64 + i * 16) * 1024); \
        P_.d[i] = *(const u32x4*)(gd + (size_t)(c_) * 256 * 64 + (size_t)i * 64 * 64); } P_.v = *(const u32x4*)(gv + (size_t)(c_) * DM * 64); P_.e = ge[(size_t)(c_) * 256]; } while (0)
#define GLA_STORE(P_) do { _Pragma("unroll") for (int i = 0; i < 4; ++i) { *(LAS u32x4*)(QD + ((tid >> 5) + i * 16) * 528 + (tid & 31) * 16) = P_.q[i]; *(LAS u32x4*)(KI + ((tid >> 5) + i * 16) * 528 + (tid & 31) * 16) = P_.k[i]; \
        *(LAS u32x4*)(KDT + ((tid >> 3) + i * 64) * 144 + (tid & 7) * 16) = P_.d[i]; } *(LAS u32x4*)(VT + (tid >> 3) * 144 + (tid & 7) * 16) = P_.v; if (tid < 256) EBL[tid] = P_.e; } while (0)
    GLA_LOAD(pfA, 0);
    const LAS unsigned char* QDl = QD + fr * 528 + quad * 16; const LAS unsigned char* KIl = KI + fr * 528 + quad * 16;
    const LAS unsigned char* KDl = KDT + (hf * 128 + fr) * 144 + quad * 16; const LAS unsigned char* VTl = VT + (dvt * 16 + fr) * 144 + quad * 16; const LAS unsigned char* ATl = AT + fr * 144 + hf * 64 + quad * 16;
    for (int c = 0; c < 32; ++c) {
        const int R0 = b * SEQ + c * 64;
        LBAR();
        GLA_STORE(pfA); if (c + 1 < 32) GLA_LOAD(pfA, c + 1);
        LBAR();
        { const int tq = wave >> 1, sq0 = 2 * (wave & 1);
          f32x4 acc0 = {0.f, 0.f, 0.f, 0.f}, acc1 = {0.f, 0.f, 0.f, 0.f}, acc2 = {0.f, 0.f, 0.f, 0.f}, acc3 = {0.f, 0.f, 0.f, 0.f};
          if (sq0 <= tq) { bf16x8 qa[8], kb[8];
#pragma unroll
              for (int ks = 0; ks < 8; ++ks) { qa[ks] = *(const LAS bf16x8*)(QDl + tq * 16 * 528 + ks * 64); kb[ks] = *(const LAS bf16x8*)(KIl + sq0 * 16 * 528 + ks * 64); }
              __builtin_amdgcn_sched_barrier(0);
#pragma unroll
              for (int ks = 0; ks < 8; ks += 2) { acc0 = MFMA16(qa[ks], kb[ks], acc0); acc1 = MFMA16(qa[ks + 1], kb[ks + 1], acc1); }
              __builtin_amdgcn_sched_barrier(0);
              if (sq0 + 1 <= tq) {
#pragma unroll
                  for (int ks = 0; ks < 8; ++ks) kb[ks] = *(const LAS bf16x8*)(KIl + (sq0 + 1) * 16 * 528 + ks * 64);
                  __builtin_amdgcn_sched_barrier(0);
#pragma unroll
                  for (int ks = 0; ks < 8; ks += 2) { acc2 = MFMA16(qa[ks], kb[ks], acc2); acc3 = MFMA16(qa[ks + 1], kb[ks + 1], acc3); }
                  __builtin_amdgcn_sched_barrier(0); } }
          acc0 = acc0 + acc1; acc2 = acc2 + acc3;
#pragma unroll
          for (int i = 0; i < 4; ++i) { const int t = tq * 16 + quad * 4 + i, s = sq0 * 16 + fr;
              *(LAS bf16*)(AT + t * 144 + s * 2) = (bf16)f2bf((s <= t) ? acc0[i] : 0.f);
              *(LAS bf16*)(AT + t * 144 + (s + 16) * 2) = (bf16)f2bf((s + 16 <= t) ? acc2[i] : 0.f); } }
        LBAR();
        f32x4 o[4];
        { bf16x8 aa[4], qa[2][4]; const bf16x8 vb = *(const LAS bf16x8*)(VTl + hf * 64);
#pragma unroll
          for (int tq = 0; tq < 4; ++tq) { aa[tq] = *(const LAS bf16x8*)(ATl + tq * 16 * 144); qa[0][tq] = *(const LAS bf16x8*)(QDl + tq * 16 * 528 + hf * 256); }
          __builtin_amdgcn_sched_barrier(0);
#pragma unroll
          for (int tq = 0; tq < 4; ++tq) o[tq] = MFMA16(aa[tq], vb, ((f32x4){0.f, 0.f, 0.f, 0.f}));
#pragma unroll
          for (int kk = 0; kk < 4; ++kk) { u32x4 bw; bw.x = pk2(st[2 * kk][0], st[2 * kk][1]); bw.y = pk2(st[2 * kk][2], st[2 * kk][3]); bw.z = pk2(st[2 * kk + 1][0], st[2 * kk + 1][1]); bw.w = pk2(st[2 * kk + 1][2], st[2 * kk + 1][3]);
              const bf16x8 bv = __builtin_bit_cast(bf16x8, bw);
              if (kk < 3) {
#pragma unroll
                  for (int tq = 0; tq < 4; ++tq) qa[(kk + 1) & 1][tq] = *(const LAS bf16x8*)(QDl + tq * 16 * 528 + hf * 256 + (kk + 1) * 64); }
              __builtin_amdgcn_sched_barrier(0);
#pragma unroll
              for (int tq = 0; tq < 4; ++tq) o[tq] = MFMA16(qa[kk & 1][tq], bv, o[tq]);
              __builtin_amdgcn_sched_barrier(0); } }
        if (hf == 1) {
#pragma unroll
            for (int tq = 0; tq < 4; ++tq)
#pragma unroll
                for (int i = 0; i < 4; ++i) OP[(tq * 16 + quad * 4 + i) * 64 + dvt * 16 + fr] = o[tq][i]; }
        { bf16x8 ka[2][4]; const bf16x8 v0 = *(const LAS bf16x8*)VTl, v1 = *(const LAS bf16x8*)(VTl + 64); f32x4 e4[8];
#pragma unroll
          for (int rt = 0; rt < 8; ++rt) e4[rt] = *(const LAS f32x4*)(EBL + hf * 128 + rt * 16 + quad * 4);
#pragma unroll
          for (int r2 = 0; r2 < 2; ++r2) { ka[0][2 * r2] = *(const LAS bf16x8*)(KDl + r2 * 16 * 144); ka[0][2 * r2 + 1] = *(const LAS bf16x8*)(KDl + r2 * 16 * 144 + 64); }
          __builtin_amdgcn_sched_barrier(0);
#pragma unroll
          for (int rp = 0; rp < 4; ++rp) {
              if (rp < 3) {
#pragma unroll
                  for (int r2 = 0; r2 < 2; ++r2) { ka[(rp + 1) & 1][2 * r2] = *(const LAS bf16x8*)(KDl + (2 * rp + 2 + r2) * 16 * 144); ka[(rp + 1) & 1][2 * r2 + 1] = *(const LAS bf16x8*)(KDl + (2 * rp + 2 + r2) * 16 * 144 + 64); } }
              st[2 * rp] = st[2 * rp] * e4[2 * rp]; st[2 * rp + 1] = st[2 * rp + 1] * e4[2 * rp + 1];
              __builtin_amdgcn_sched_barrier(0);
              st[2 * rp] = MFMA16(ka[rp & 1][0], v0, st[2 * rp]); st[2 * rp + 1] = MFMA16(ka[rp & 1][2], v0, st[2 * rp + 1]);
              st[2 * rp] = MFMA16(ka[rp & 1][1], v1, st[2 * rp]); st[2 * rp + 1] = MFMA16(ka[rp & 1][3], v1, st[2 * rp + 1]);
              __builtin_amdgcn_sched_barrier(0); } }
        LBAR();
        if (hf == 0) { float opv[16];
#pragma unroll
            for (int tq = 0; tq < 4; ++tq)
#pragma unroll
                for (int i = 0; i < 4; ++i) opv[tq * 4 + i] = OP[(tq * 16 + quad * 4 + i) * 64 + dvt * 16 + fr];
            __builtin_amdgcn_sched_barrier(0);
            bf16* oa = OA + (size_t)(R0 + quad * 4) * DM + h * 512 + slice * 64 + dvt * 16 + fr;
#pragma unroll
            for (int tq = 0; tq < 4; ++tq)
#pragma unroll
                for (int i = 0; i < 4; ++i) oa[(size_t)(tq * 16 + i) * DM] = (bf16)f2bf(o[tq][i] + opv[tq * 4 + i]); }
    }
#undef GLA_LOAD
#undef GLA_STORE
    __syncthreads();
}

#define FOX_DMA(jj_, st_) do { _Pragma("unroll") for (int i_ = 0; i_ < 2; ++i_) { \
        __builtin_amdgcn_global_load_lds((const unsigned*)(kgp[i_] + (size_t)(jj_) * 64 * DM), (LAS unsigned*)(lds + (st_) * 32768 + (wave * 2 + i_) * 1024), 16, 0, 0); \
        __builtin_amdgcn_global_load_lds((const unsigned*)(vgp[i_] + (size_t)(jj_) * DM * 64), (LAS unsigned*)(lds + (st_) * 32768 + 16384 + (wave * 2 + i_) * 1024), 16, 0, 0); } } while (0)
template <int ST>
__device__ __forceinline__ void fox_tile(LAS unsigned char* lds, const LAS float* CUM, int wave, int lane, int fr, int quad, int j, int ntile, int q0,
                                         const bf16* const (&kgp)[2], const bf16* const (&vgp)[2], const unsigned (&kro)[4], const unsigned (&vro)[2],
                                         const bf16x8 (&qf)[2][4], f32x4 (&o)[2][8], float (&mrun)[2], float (&lrun)[2]) {
    const float SCL = 0.08838834764831845f * 1.4426950408889634f;
    if (j + 1 < ntile) FOX_DMA(j + 1, ST ^ 1);
    if (j * 64 <= q0 + 31) {
    const LAS unsigned char* KTs = lds + ST * 32768; const LAS unsigned char* VTs = lds + ST * 32768 + 16384;
    f32x4 s[2][4]; bf16x8 kf[4];
#define KFRAG(i_) (*(const LAS bf16x8*)(KTs + ((i_) >> 2) * 4096 + kro[(i_) & 3]))
    kf[0] = KFRAG(0); kf[1] = KFRAG(1); kf[2] = KFRAG(2);
#pragma unroll
    for (int mt = 0; mt < 4; ++mt) { s[0][mt] = (f32x4){0.f, 0.f, 0.f, 0.f}; s[1][mt] = (f32x4){0.f, 0.f, 0.f, 0.f}; }
#pragma unroll
    for (int i = 0; i < 16; ++i) {
        if (i + 3 < 16) kf[(i + 3) & 3] = KFRAG(i + 3);
        __builtin_amdgcn_sched_barrier(0);
        s[0][i >> 2] = MFMA16(kf[i & 3], qf[0][i & 3], s[0][i >> 2]); s[1][i >> 2] = MFMA16(kf[i & 3], qf[1][i & 3], s[1][i >> 2]);
        __builtin_amdgcn_sched_barrier(0); }
#undef KFRAG
    bf16x8 vf[3];
#define VFRAG(i_) (*(const LAS bf16x8*)(VTs + ((i_) >> 1) * 2048 + vro[(i_) & 1]))
    vf[0] = VFRAG(0); vf[1] = VFRAG(1);
    const bool diag = (j * 64 + 63 > q0);
    bf16x8 pb[2][2];
#pragma unroll
    for (int sub = 0; sub < 2; ++sub) { const int q = q0 + sub * 16 + fr; float mx = -__builtin_inff();
#pragma unroll
        for (int mt = 0; mt < 4; ++mt) { const f32x4 ck = *(const LAS f32x4*)(CUM + j * 64 + mt * 16 + quad * 4);
#pragma unroll
            for (int i = 0; i < 4; ++i) { float v = fmaf(s[sub][mt][i], SCL, ck[i]);
                if (diag && (j * 64 + mt * 16 + quad * 4 + i > q)) v = -__builtin_inff();
                s[sub][mt][i] = v; mx = fmaxf(mx, v); } }
        mx = fmaxf(mx, shx(mx, 16, lane)); mx = fmaxf(mx, shx(mx, 32, lane));
        if (!__all(mx - mrun[sub] <= 8.f)) {
            const float mn = fmaxf(mrun[sub], mx), alpha = __builtin_amdgcn_exp2f(mrun[sub] - mn); mrun[sub] = mn; lrun[sub] *= alpha;
#pragma unroll
            for (int d = 0; d < 8; ++d) o[sub][d] = o[sub][d] * alpha; }
        const float mn = mrun[sub]; float ps = 0.f;
#pragma unroll
        for (int mt = 0; mt < 4; ++mt)
#pragma unroll
            for (int i = 0; i < 4; ++i) { const float p = __builtin_amdgcn_exp2f(s[sub][mt][i] - mn); s[sub][mt][i] = p; ps += p; }
        lrun[sub] += ps;
#pragma unroll
        for (int k2 = 0; k2 < 2; ++k2) { u32x4 w; w.x = pk2(s[sub][2 * k2][0], s[sub][2 * k2][1]); w.y = pk2(s[sub][2 * k2][2], s[sub][2 * k2][3]);
            w.z = pk2(s[sub][2 * k2 + 1][0], s[sub][2 * k2 + 1][1]); w.w = pk2(s[sub][2 * k2 + 1][2], s[sub][2 * k2 + 1][3]); pb[sub][k2] = __builtin_bit_cast(bf16x8, w); } }
    __builtin_amdgcn_sched_barrier(0);
#pragma unroll
    for (int i = 0; i < 16; ++i) {
        if (i + 2 < 16) vf[(i + 2) % 3] = VFRAG(i + 2);
        __builtin_amdgcn_sched_barrier(0);
        o[0][i >> 1] = MFMA16(vf[i % 3], pb[0][i & 1], o[0][i >> 1]); o[1][i >> 1] = MFMA16(vf[i % 3], pb[1][i & 1], o[1][i >> 1]);
        __builtin_amdgcn_sched_barrier(0); }
#undef VFRAG
    }
    asm volatile("s_waitcnt vmcnt(0)" ::: "memory");
    LBAR();
}
__device__ __forceinline__ void fox_item(const Args& a, LAS unsigned char* lds, int item, int tid_in, int wave, int lane_in) {
    unsigned char* ws = a.ws;
    int tid = tid_in; asm volatile("" : "+v"(tid)); (void)lane_in;
    const int bh = item >> 2, x = item & 3, b = bh >> 4, h = bh & 15;
    LAS float* CUM = (LAS float*)(lds + 65536);
    const bf16* FQ = (const bf16*)(ws + WS_FQ); const bf16* FK = (const bf16*)(ws + WS_FK); const bf16* FVT = (const bf16*)(ws + WS_FVT);
    bf16* OB = (bf16*)((unsigned char*)a.out + 64 * MiB);
    __syncthreads();
    *(LAS f32x4*)(CUM + tid * 4) = *(const f32x4*)((const float*)(ws + WS_CUMG) + (size_t)bh * SEQ + tid * 4);
    __syncthreads();
    for (int pass = 0; pass < 2; ++pass) {
        const int lane = my_lane(), fr = lane & 15, quad = lane >> 4;
        const int qb = pass ? 7 - x : x, ntile = (qb + 1) * 4, q0 = qb * 256 + wave * 32;
        bf16x8 qf[2][4]; float mrun[2], lrun[2]; f32x4 o[2][8];
#pragma unroll
        for (int sub = 0; sub < 2; ++sub) { const int q = q0 + sub * 16 + fr; mrun[sub] = -1e30f; lrun[sub] = 0.f;
#pragma unroll
            for (int ks = 0; ks < 4; ++ks) qf[sub][ks] = *(const bf16x8*)(FQ + (size_t)(b * SEQ + q) * DM + h * 128 + ks * 32 + quad * 8);
#pragma unroll
            for (int d = 0; d < 8; ++d) o[sub][d] = (f32x4){0.f, 0.f, 0.f, 0.f}; }
        const bf16* kgp[2]; const bf16* vgp[2];
#pragma unroll
        for (int i = 0; i < 2; ++i) { const int L = (wave * 2 + i) * 64 + lane;
            { const int row = L >> 4, c = (L & 15) ^ (row & 15); kgp[i] = FK + (size_t)(b * SEQ + row) * DM + h * 128 + c * 8; }
            { const int row = L >> 3, c = (L & 7) ^ ((row >> 1) & 7); vgp[i] = FVT + ((size_t)(b * 32) * DM + h * 128 + row) * 64 + c * 8; } }
        unsigned kro[4], vro[2];
#pragma unroll
        for (int ks = 0; ks < 4; ++ks) kro[ks] = (unsigned)(fr * 256 + (((ks * 4 + quad) ^ fr) << 4));
#pragma unroll
        for (int k2 = 0; k2 < 2; ++k2) vro[k2] = (unsigned)(fr * 128 + (((k2 * 4 + quad) ^ ((fr >> 1) & 7)) << 4));
        FOX_DMA(0, 0);
        asm volatile("s_waitcnt vmcnt(0)" ::: "memory");
        LBAR();
        for (int j = 0; j < ntile; j += 2) {
            fox_tile<0>(lds, CUM, wave, lane, fr, quad, j, ntile, q0, kgp, vgp, kro, vro, qf, o, mrun, lrun);
            fox_tile<1>(lds, CUM, wave, lane, fr, quad, j + 1, ntile, q0, kgp, vgp, kro, vro, qf, o, mrun, lrun);
        }
#pragma unroll
        for (int sub = 0; sub < 2; ++sub) { float lt = lrun[sub]; lt += shx(lt, 16, lane); lt += shx(lt, 32, lane); const float inv = 1.f / lt; bf16* op = OB + (size_t)(b * SEQ + q0 + sub * 16 + fr) * DM + h * 128 + quad * 4;
#pragma unroll
            for (int d = 0; d < 8; ++d) { u32x2 w; w.x = pk2(o[sub][d][0] * inv, o[sub][d][1] * inv); w.y = pk2(o[sub][d][2] * inv, o[sub][d][3] * inv); *(u32x2*)(op + d * 16) = w; } }
    }
    __syncthreads();
}
#undef FOX_DMA

__device__ __forceinline__ void fix_row(const Args& a, int row, int lane) {
    unsigned char* ws = a.ws; bf16* OA = (bf16*)(ws + WS_OA) + (size_t)row * DM; const bf16* GG = (const bf16*)(ws + WS_GG) + (size_t)row * DM;
    const f32x4 g0 = *(const f32x4*)(a.in[8] + lane * 8), g1 = *(const f32x4*)(a.in[8] + lane * 8 + 4);
#pragma unroll
    for (int hh = 0; hh < 4; ++hh) { const u32x4 w = *(const u32x4*)(OA + hh * 512 + lane * 8); const u32x4 gw = *(const u32x4*)(GG + hh * 512 + lane * 8);
        float v[8] = {bflo(w.x), bfhi(w.x), bflo(w.y), bfhi(w.y), bflo(w.z), bfhi(w.z), bflo(w.w), bfhi(w.w)};
        float gv[8] = {bflo(gw.x), bfhi(gw.x), bflo(gw.y), bfhi(gw.y), bflo(gw.z), bfhi(gw.z), bflo(gw.w), bfhi(gw.w)};
        float ss = 0.f;
#pragma unroll
        for (int e = 0; e < 8; ++e) ss += v[e] * v[e];
        const float rstd = rsqrtf(wave_sum(ss, lane) * (1.f / 512.f) + EPS);
        float r[8];
#pragma unroll
        for (int e = 0; e < 8; ++e) { const float gl = e < 4 ? g0[e] : g1[e - 4]; r[e] = v[e] * rstd * gl * (gv[e] * sigmoidf_(gv[e])); }
        u32x4 ow; ow.x = pk2(r[0], r[1]); ow.y = pk2(r[2], r[3]); ow.z = pk2(r[4], r[5]); ow.w = pk2(r[6], r[7]);
        *(u32x4*)(OA + hh * 512 + lane * 8) = ow; }
}
__device__ __forceinline__ void final_finish(const RowRegs& R, float* orow, const float* g, int lane) {
    float ss = 0.f;
#pragma unroll
    for (int j = 0; j < 8; ++j) ss += (R.v[j][0] * R.v[j][0] + R.v[j][1] * R.v[j][1]) + (R.v[j][2] * R.v[j][2] + R.v[j][3] * R.v[j][3]);
    const float rstd = rsqrtf(wave_sum(ss, lane) * (1.f / DM) + EPS);
#pragma unroll
    for (int j = 0; j < 8; ++j) { const int col = row_col<true>(j, lane); const f32x4 gg = *(const f32x4*)(g + col); *(f32x4*)(orow + col) = R.v[j] * rstd * gg; }
}

#define XB_TMO      128
#define XB_XCNT(j)  (256  + 64 * (j))
#define XB_XSUB(j)  (1280 + 64 * (j))
#define XB_XGEN(j)  (2304 + 64 * (j))
#define XB_TOP      3328
#define XB_TOPGEN   3392
#define XCD_BAR_WORDS 3456
#define XB_SPIN_CAP (1u << 18)

__device__ __forceinline__ unsigned xb_ld(unsigned* p)              { return __hip_atomic_load(p, __ATOMIC_RELAXED, __HIP_MEMORY_SCOPE_AGENT); }
__device__ __forceinline__ unsigned xb_add(unsigned* p, unsigned v) { return __hip_atomic_fetch_add(p, v, __ATOMIC_RELAXED, __HIP_MEMORY_SCOPE_AGENT); }
__device__ __forceinline__ unsigned xb_xcc_id() { return (unsigned)__builtin_amdgcn_s_getreg((3 << 11) | 20) & 0xFu; }
#define XB_SPIN(cond, bar) do { unsigned _sp = 0; while (cond) { __builtin_amdgcn_s_sleep(1); \
    if ((++_sp & 255u) == 0u) { if (xb_ld(&(bar)[XB_TMO])) break; if (_sp > XB_SPIN_CAP) { atomicAdd(&(bar)[XB_TMO], 1u); break; } } } } while (0)

struct XcdBarrier {
    unsigned* bar; unsigned x;
    volatile LAS unsigned* st;
};

__device__ __forceinline__ XcdBarrier xcd_barrier_post(unsigned* bar, volatile LAS unsigned* st, int tid_) {
    XcdBarrier b; b.bar = bar; b.x = xb_xcc_id(); b.st = st;
    if (tid_ == 0) st[2] = xb_add(&bar[XB_XCNT(b.x)], 1u);
    return b;
}
__device__ __forceinline__ void xcd_barrier_complete(unsigned* bar, unsigned x, unsigned& nloc, unsigned& nx) {
    const unsigned G = gridDim.x * gridDim.y * gridDim.z;
    unsigned sum, cnt, mine, sp = 0u;
    for (;;) {
        sum = 0u; cnt = 0u; mine = 0u;
#pragma unroll
        for (unsigned j = 0; j < 16; ++j) { const unsigned c = xb_ld(&bar[XB_XCNT(j)]); sum += c; cnt += (c > 0u) ? 1u : 0u; mine = (j == x) ? c : mine; }
        if (sum == G) break;
        __builtin_amdgcn_s_sleep(1);
        if ((++sp & 255u) == 0u) { if (xb_ld(&bar[XB_TMO])) break; if (sp > XB_SPIN_CAP) { atomicAdd(&bar[XB_TMO], 1u); break; } }
    }
    nloc = mine > 0u ? mine : 1u; nx = cnt > 0u ? cnt : 1u;
}

__device__ __forceinline__ void xcd_barrier(const XcdBarrier& b, int tid_) {
    asm volatile("s_waitcnt vmcnt(0)" ::: "memory");
    __syncthreads();
    if (tid_ == 0) {
        unsigned* bar = b.bar;
        __builtin_amdgcn_s_waitcnt(0);
        unsigned nloc = b.st[0], nx = b.st[1];
        if (nloc == 0u) { xcd_barrier_complete(bar, b.x, nloc, nx); b.st[0] = nloc; b.st[1] = nx; }
        const unsigned old = xb_add(&bar[XB_XSUB(b.x)], 1u);
        const unsigned gen = old / nloc;
        if (old + 1u == (gen + 1u) * nloc) {
            __builtin_amdgcn_fence(__ATOMIC_RELEASE, "agent");
            asm volatile("s_waitcnt vmcnt(0)" ::: "memory");
            const unsigned og = xb_add(&bar[XB_TOP], 1u);
            const unsigned tg = og / nx;
            if (og + 1u == (tg + 1u) * nx) xb_add(&bar[XB_TOPGEN], 1u);
            else XB_SPIN(xb_ld(&bar[XB_TOPGEN]) == tg, bar);
            __builtin_amdgcn_fence(__ATOMIC_ACQUIRE, "agent");
            xb_add(&bar[XB_XGEN(b.x)], 1u);
            asm volatile("s_waitcnt vmcnt(0)" ::: "memory");
        } else {
            XB_SPIN(xb_ld(&bar[XB_XGEN(b.x)]) == gen, bar);
            __builtin_amdgcn_fence(__ATOMIC_ACQUIRE, "agent");
            asm volatile("s_waitcnt vmcnt(0)" ::: "memory");
        }
    }
    __syncthreads();
}

#define WGM_G1A 4
#define WGM_G1B 4
#define WGM_DUAL 4
#define WGM_G3 4
#define WGM_G4 4
#define WGM_G5 4
#define REP_P0 1
#define REP_G1A 1
#define REP_GLA 1
#define REP_FOX 1
#define REP_G4 1
#define REP_G3 1
#define REP_P1 1
#define REP_P7 1
#define REP_G1B 1
#define REP_G2A 1
#define REP_G2B 1
__global__ void __launch_bounds__(512, 2) hybrid_fwd(Args a) {
    extern __shared__ __attribute__((aligned(16))) unsigned char lds_raw[];
    LAS unsigned char* lds = (LAS unsigned char*)lds_raw;
    cg::grid_group grid = cg::this_grid();
    const int G = gridDim.x, NGW = G * 8;
    const int wave0 = __builtin_amdgcn_readfirstlane((int)(threadIdx.x >> 6));
#define MYTID() (wave0 * 64 + my_lane())
    unsigned* barw = (unsigned*)(a.ws + WS_CTL);
    volatile LAS unsigned* MISC = (volatile LAS unsigned*)(lds + LDS_BYTES - 64);
    { const int t0 = MYTID(); if (t0 < 16) MISC[t0] = 0u;
      if (blockIdx.x == 0) for (int i = t0; i < XCD_BAR_WORDS; i += 512) barw[i] = 0u; }
    __syncthreads();
#define FRESH() int tid = MYTID(); asm volatile("" : "+v"(tid)); const int lane = tid & 63, wave = __builtin_amdgcn_readfirstlane(tid >> 6), gw = blockIdx.x * 8 + wave; (void)lane; (void)gw
    unsigned char* ws = a.ws;
    const float* MOD = (const float*)(ws + WS_MOD);

    for (int rep = 0; rep < REP_P0; ++rep) { FRESH(); p0_phase(a, lds, gw, NGW, wave, lane); __syncthreads(); }
    grid.sync();
    const XcdBarrier xbar = xcd_barrier_post(barw, MISC, MYTID());
#define GRID_BAR() do { unsigned long long bp_ = (unsigned long long)(a.ws + WS_CTL); asm volatile("" : "+s"(bp_)); XcdBarrier xb_ = xbar; xb_.bar = (unsigned*)bp_; xcd_barrier(xb_, MYTID()); } while (0)
    for (int rep = 0; rep < REP_P1; ++rep) { FRESH(); p1_phase(a, lds, tid, wave, lane); }
    GRID_BAR();
    for (int rep = 0; rep < REP_G1A; ++rep) {
        pg8::Gemm g{(const bf16*)a.out, (const bf16*)(ws + WS_WINLO), MT, N1A, DM, nullptr, nullptr}; pg8::StaticOrder S; S.init(MT, N1A, G, (int)blockIdx.x, WGM_G1A);
        EpiProj E{ws};
        pg8::gemm_phase<EpiProj, pg8::StaticOrder, true, true>(lds, g, S, E, MYTID());
    }
    GRID_BAR();
    { FRESH(); for (int it = blockIdx.x; it < 1024; it += G) gla_prep_unit(a, lds, it, tid);
      __syncthreads();
      for (int it = blockIdx.x; it < 128; it += G) cum_item(a, lds, it, tid, wave, lane); }
    GRID_BAR();
    int vb = (int)blockIdx.x;
    if (G == 256) { bool even = true;
        for (unsigned j = 0; j < 8; ++j) even = even && (xb_ld(&barw[XB_XCNT(j)]) == 32u);
        const unsigned xr = MISC[2];
        vb = (even && xbar.x < 8u && xr < 32u) ? (int)(xbar.x * 32u + xr) : (int)((blockIdx.x & 7) * 32 + (blockIdx.x >> 3)); }
    vb = __builtin_amdgcn_readfirstlane(vb);
    for (int rep = 0; rep < REP_GLA; ++rep)
    for (int it = vb; it < 256; it += G) { FRESH(); gla_item(a, lds, it, tid, wave, lane); }
    for (int rep = 0; rep < REP_FOX; ++rep)
    for (int it = vb; it < 512; it += G) { FRESH(); fox_item(a, lds, it, tid, wave, lane); }
    GRID_BAR();
    {
        FRESH();
        for (int row = gw; row < MT; row += NGW) fix_row(a, row, lane);
        LAS float* scr = (LAS float*)(lds + wave * 16896);
        for (int it = gw; it < 32 * 128; it += NGW) tr_plain(a.in[14], DM, DFF, (bf16*)(ws + WS_W1), it, scr, lane);
        for (int it = gw; it < 128 * 32; it += NGW) tr_plain(a.in[15], DFF, DM, (bf16*)(ws + WS_W2), it, scr, lane);
        { unsigned* z = (unsigned*)(ws + WS_ROWSS); for (int i = gw * 64 + lane; i < (229376 - 65536) / 4; i += NGW * 64) z[i] = 0u; }
        __syncthreads();
        pg8::Gemm g{(const bf16*)a.out, (const bf16*)(ws + WS_WINHI), MT, N1B, DM, nullptr, nullptr}; pg8::StaticOrder S; S.init(MT, N1B, G, (int)blockIdx.x, WGM_G1B);
        EpiGen<0> E{(bf16*)(ws + WS_SGA), 2048, nullptr, nullptr, nullptr, nullptr, nullptr};
        for (int rep = 0; rep < REP_G1B; ++rep) pg8::gemm_phase<EpiGen<0>, pg8::StaticOrder, true, true>(lds, g, S, E, MYTID());
    }
    GRID_BAR();
    {
        pg8::DualOrder S; S.init(MT, DM, G, (int)blockIdx.x, WGM_DUAL);
        pg8::Gemm g{(const bf16*)(ws + WS_OA), (const bf16*)(ws + WS_WA), MT, DM, DM, (const bf16*)((unsigned char*)a.out + 64 * MiB), (const bf16*)(ws + WS_WB)};
        EpiDual E{(bf16*)(ws + WS_MG), (const bf16*)(ws + WS_SGA), (const bf16*)(ws + WS_SGB)};
        pg8::gemm_phase<EpiDual, pg8::DualOrder, true, true>(lds, g, S, E, MYTID());
    }
    GRID_BAR();
    for (int rep = 0; rep < REP_G3; ++rep) {
        pg8::Gemm g{(const bf16*)(ws + WS_MG), (const bf16*)(ws + WS_WO), MT, DM, DM, nullptr, nullptr}; pg8::StaticOrder S; S.init(MT, DM, G, (int)blockIdx.x, WGM_G3);
        if (G == 256) {
            EpiMid E{(bf16*)(ws + WS_X1B), (bf16*)(ws + WS_H2), a.in[0], MOD, a.in[13], (float*)(ws + WS_ROWSS2), (unsigned*)(ws + WS_PCNT2), (LAS float*)(lds + 131072)};
            pg8::gemm_phase<EpiMid, pg8::StaticOrder, true, true>(lds, g, S, E, MYTID());
        } else {
            EpiGen<5> E{(bf16*)(ws + WS_X1B), 2048, nullptr, nullptr, a.in[0], nullptr, MOD + 2 * DM};
            pg8::gemm_phase<EpiGen<5>, pg8::StaticOrder, true, true>(lds, g, S, E, MYTID());
        }
    }
    GRID_BAR();
    if (G != 256) {
        FRESH();
        bf16* H2 = (bf16*)(ws + WS_H2);
        for (int row = 2 * gw; row < MT; row += 2 * NGW) { const float* mb = MOD + (size_t)(row / SEQ) * NMOD; RowRegs R0, R1;
            row_load_b16(R0, (const bf16*)(ws + WS_X1B) + (size_t)row * DM, lane); row_load_b16(R1, (const bf16*)(ws + WS_X1B) + (size_t)(row + 1) * DM, lane);
            norm_finish_bf16<const float*, true>(R0, a.in[13], mb + 4 * DM, mb + 3 * DM, H2 + (size_t)row * DM, lane);
            norm_finish_bf16<const float*, true>(R1, a.in[13], mb + 4 * DM, mb + 3 * DM, H2 + (size_t)(row + 1) * DM, lane); }
        __syncthreads();
        GRID_BAR();
    }
    for (int rep = 0; rep < REP_G4; ++rep) {
        pg8::Gemm g{(const bf16*)(ws + WS_H2), (const bf16*)(ws + WS_W1), MT, DFF, DM, nullptr, nullptr}; pg8::StaticOrder S; S.init(MT, DFF, G, (int)blockIdx.x, WGM_G4);
        EpiGen<4> E{(bf16*)(ws + WS_U), DFF, nullptr, nullptr, nullptr, nullptr, nullptr};
        pg8::gemm_phase<EpiGen<4>, pg8::StaticOrder, true, true>(lds, g, S, E, MYTID());
    }
    GRID_BAR();
    {
        pg8::Gemm g{(const bf16*)(ws + WS_U), (const bf16*)(ws + WS_W2), MT, DM, DFF, nullptr, nullptr}; pg8::StaticOrder S; S.init(MT, DM, G, (int)blockIdx.x, WGM_G5);
        if (G == 256) {
            EpiFinal E{a.out, (const bf16*)(ws + WS_X1B), MOD + 5 * DM, a.in[16], (float*)(ws + WS_ROWSS), (unsigned*)(ws + WS_PCNT), (LAS float*)(lds + 131072)};
            pg8::gemm_phase<EpiFinal, pg8::StaticOrder, true, true>(lds, g, S, E, MYTID());
        } else {
            EpiGen<6> E{(bf16*)(ws + WS_X2B), 2048, (const bf16*)(ws + WS_X1B), nullptr, nullptr, nullptr, MOD + 5 * DM};
            pg8::gemm_phase<EpiGen<6>, pg8::StaticOrder, true, true>(lds, g, S, E, MYTID());
        }
    }
    if (G != 256) {
        GRID_BAR();
        { FRESH(); for (int row = 2 * gw; row < MT; row += 2 * NGW) { RowRegs R0, R1; const bf16* X2B = (const bf16*)(ws + WS_X2B); row_load_b16(R0, X2B + (size_t)row * DM, lane); row_load_b16(R1, X2B + (size_t)(row + 1) * DM, lane);
            final_finish(R0, a.out + (size_t)row * DM, a.in[16], lane); final_finish(R1, a.out + (size_t)(row + 1) * DM, a.in[16], lane); } }
    }
}

extern "C" void kernel_launch(void* const* d_in, const int* in_sizes, int n_in, void* d_out, int out_size, void* d_ws, size_t ws_size, hipStream_t stream) {
    static int grid = 0;
    if (grid == 0) {
        if (n_in != 17 || out_size != MT * DM || ws_size < WS_END) { fprintf(stderr, "kernel_launch: unexpected shapes (n_in %d out %d ws %zu)\n", n_in, out_size, ws_size); grid = -1; return; }
        int dev = 0, cus = 0, per_cu = 0;
        (void)hipGetDevice(&dev); (void)hipDeviceGetAttribute(&cus, hipDeviceAttributeMultiprocessorCount, dev);
        (void)hipFuncSetAttribute((const void*)hybrid_fwd, hipFuncAttributeMaxDynamicSharedMemorySize, LDS_BYTES);
        (void)hipOccupancyMaxActiveBlocksPerMultiprocessor(&per_cu, (const void*)hybrid_fwd, 512, LDS_BYTES);
        if (per_cu < 1) { fprintf(stderr, "kernel_launch: occupancy query says %d blocks per CU\n", per_cu); per_cu = 1; }
        (void)hipGetLastError();
        grid = cus > 0 ? cus : 256;
    }
    if (grid < 0) return;
    Args a{};
    for (int i = 0; i < 17; ++i) a.in[i] = (const float*)d_in[i];
    a.out = (float*)d_out; a.ws = (unsigned char*)d_ws;
    void* args[] = {&a};
    hipError_t e = hipLaunchCooperativeKernel((const void*)hybrid_fwd, dim3(grid), dim3(512), args, LDS_BYTES, stream);
    if (e != hipSuccess) fprintf(stderr, "cooperative launch failed: %s (grid %d)\n", hipGetErrorString(e), grid);
}
```

```cpp
#include <hip/hip_runtime.h>
#include <hip/hip_cooperative_groups.h>
#include <cstdio>
#include <cstdint>
namespace cg = cooperative_groups;
namespace pg8 {
#define PG8_LAS __attribute__((address_space(3)))
typedef unsigned short bf16_t;
typedef short bf16x8 __attribute__((ext_vector_type(8)));
typedef float f32x4 __attribute__((ext_vector_type(4)));
typedef unsigned u32x4 __attribute__((ext_vector_type(4)));
constexpr int BM = 256, BK = 64, HALF = 128, HTB = HALF * BK * 2  , STAGE_BYTES = 8 * HTB, NXCD = 8, WGM = 4;

__host__ __device__ __forceinline__ int lds_byte(int r, int c) { const int st = (r >> 4) * 2 + (c >> 5), rr = r & 15, cc = c & 31, ob = rr * 64 + cc * 2; return st * 1024 + (ob ^ (((ob >> 9) & 1) << 5)); }
__host__ __device__ __forceinline__ void stage_rc(int b, int& R, int& C) { const int st = b / 1024, sb = b % 1024, swz = sb ^ (((sb >> 9) & 1) << 5); R = (st >> 1) * 16 + swz / 64; C = (st & 1) * 32 + (swz % 64) / 2; }
__host__ __device__ __forceinline__ int perm32(int rho) { const int n = rho >> 4, i = rho & 15; return 8 * (i >> 2) + 4 * n + (i & 3); }

struct Unit { int pm, pn, z; };
struct Gemm { const bf16_t* A; const bf16_t* Bt; int M, N, K; const bf16_t* A2; const bf16_t* Bt2; };

struct StaticOrder {
    int nM, nN, nwg, G, c, wgm;
    __host__ __device__ void init(int M, int N, int G_, int c_, int wgm_ = WGM) { nM = M / BM; nN = N / BM; nwg = nM * nN; G = G_; c = c_; wgm = wgm_; }
    __host__ __device__ bool next(int i, Unit& u) const {
        const long L = (long)i * G + c; if (L >= nwg) return false;
        int wgid = (int)L; { const int q = nwg / NXCD, r = nwg % NXCD, xcd = wgid % NXCD, off = wgid / NXCD; wgid = (xcd < r ? xcd * (q + 1) : r * (q + 1) + (xcd - r) * q) + off; }
        const int nig = wgm * nN, gid = wgid / nig, fm = gid * wgm, gsz = (nM - fm) < wgm ? (nM - fm) : wgm;
        u.pm = fm + ((wgid % nig) % gsz); u.pn = (wgid % nig) / gsz; u.z = 0; return true;
    }
    __device__ __forceinline__ void a_ready(const Unit&) const {}
    __device__ __forceinline__ void done(const Unit&) const {}
};
struct DualOrder {
    StaticOrder base;
    __host__ __device__ void init(int M, int N, int G_, int c_, int wgm_ = WGM) { base.init(M, N, G_, c_, wgm_); }
    __host__ __device__ bool next(int i, Unit& u) const { if (!base.next(i >> 1, u)) return false; u.z = i & 1; return true; }
    __device__ __forceinline__ void a_ready(const Unit&) const {}
    __device__ __forceinline__ void done(const Unit&) const {}
};

__device__ __forceinline__ unsigned cvt_pk_bf16(float lo, float hi) { unsigned r; asm volatile("v_cvt_pk_bf16_f32 %0, %1, %2" : "=v"(r) : "v"(lo), "v"(hi)); return r; }
typedef float f32x2 __attribute__((ext_vector_type(2)));
template <class Epi, class Sched, bool ALIGN_EPI = false, bool SP2 = false>
__device__ __forceinline__ void gemm_phase(PG8_LAS unsigned char* lds, const Gemm g, const Sched& S, const Epi& E, int tid_in) {
    int tid_l = tid_in; asm volatile("" : "+v"(tid_l)); const int tid = tid_l, wid = __builtin_amdgcn_readfirstlane(tid >> 6), lane = tid & 63, wr = wid >> 2, wc = wid & 3, fr = lane & 15, fq = lane >> 4;
    const int K = g.K, nt = K / BK;
    unsigned voffA[2], voffB[2];
#pragma unroll
    for (int i = 0; i < 2; ++i) { int R, C; stage_rc(tid * 16 + i * 8192, R, C); const int Rb = Epi::PERM ? ((R & ~31) + perm32(R & 31)) : R;
        voffA[i] = (unsigned)(R * K + C) * 2u; voffB[i] = (unsigned)(Rb * K + C) * 2u; }
    const size_t kstep = (size_t)(BK * 2);
    const size_t hstep = (size_t)HALF * K * 2;
    const size_t tstep = 2 * hstep;
    const unsigned ldsw = (unsigned)wid * 1024u;
    const int aoff = lds_byte(wr * 64 + fr, fq * 8), boff = lds_byte(wc * 32 + fr, fq * 8);
#define PG8_SA(b, h) (((b) * 2 + (h)) * HTB)
#define PG8_SB(b, h) ((4 + (b) * 2 + (h)) * HTB)
#define PG8_STAGE(bufoff, gbase, voff) do { _Pragma("unroll") for (int _i = 0; _i < 2; ++_i) \
        __builtin_amdgcn_global_load_lds((const unsigned*)((const char*)(gbase) + (voff)[_i]), (PG8_LAS unsigned*)(lds + (bufoff) + ldsw + _i * 8192), 16, 0, 0); } while (0)
#define PG8_LDA(dst, b, h) do { _Pragma("unroll") for (int m = 0; m < 4; ++m) _Pragma("unroll") for (int k = 0; k < 2; ++k) dst[m][k] = *(const PG8_LAS bf16x8*)(lds + PG8_SA(b, h) + aoff + m * 2048 + k * 1024); } while (0)
#define PG8_LDB(dst, b, h) do { _Pragma("unroll") for (int n = 0; n < 2; ++n) _Pragma("unroll") for (int k = 0; k < 2; ++k) dst[n][k] = *(const PG8_LAS bf16x8*)(lds + PG8_SB(b, h) + boff + n * 2048 + k * 1024); } while (0)
#define PG8_MMA(ai, bj, At, Bt) do { __builtin_amdgcn_s_setprio(1); _Pragma("unroll") for (int m = 0; m < 4; ++m) _Pragma("unroll") for (int n = 0; n < 2; ++n) _Pragma("unroll") for (int k = 0; k < 2; ++k) \
        acc[ai][bj][m][n] = __builtin_amdgcn_mfma_f32_16x16x32_bf16(Bt[n][k], At[m][k], acc[ai][bj][m][n], 0, 0, 0); __builtin_amdgcn_s_setprio(0); } while (0)
#define PG8_WAIT_V(n) asm volatile("s_waitcnt vmcnt(" #n ")" ::: "memory")
#define PG8_WAIT_L(n) asm volatile("s_waitcnt lgkmcnt(" #n ")" ::: "memory")
#define PG8_BAR __builtin_amdgcn_s_barrier()
#define PG8_SCHED __builtin_amdgcn_sched_barrier(0)
    Unit cur, nxt; int ui = 0;
    if (!S.next(0, cur)) return;
    f32x4 acc[2][2][4][2];
#pragma unroll
    for (int a = 0; a < 2; ++a)
#pragma unroll
        for (int b = 0; b < 2; ++b)
#pragma unroll
            for (int m = 0; m < 4; ++m)
#pragma unroll
                for (int n = 0; n < 2; ++n) acc[a][b][m][n] = (f32x4){0.f, 0.f, 0.f, 0.f};
    bf16x8 At[4][2], B0[2][2], B1[2][2];
    const char* cA = (const char*)(cur.z ? g.A2 : g.A) + (size_t)cur.pm * tstep; const char* cB = (const char*)(cur.z ? g.Bt2 : g.Bt) + (size_t)cur.pn * tstep;
    S.a_ready(cur);
    if constexpr (SP2) {
        PG8_STAGE(PG8_SB(0, 0), cB, voffB); PG8_STAGE(PG8_SB(0, 1), cB + hstep, voffB); PG8_STAGE(PG8_SA(0, 0), cA, voffA); PG8_STAGE(PG8_SA(0, 1), cA + hstep, voffA);
        if (wr == 1) PG8_BAR;
        PG8_WAIT_V(2); PG8_BAR;
        PG8_STAGE(PG8_SB(1, 0), cB + kstep, voffB); PG8_STAGE(PG8_SA(1, 0), cA + kstep, voffA); PG8_STAGE(PG8_SB(1, 1), cB + hstep + kstep, voffB);
        PG8_WAIT_V(6); PG8_BAR;
    } else {
        PG8_STAGE(PG8_SB(0, 0), cB, voffB); PG8_STAGE(PG8_SA(0, 0), cA, voffA); PG8_STAGE(PG8_SB(0, 1), cB + hstep, voffB); PG8_STAGE(PG8_SA(0, 1), cA + hstep, voffA);
        if (wr == 1) PG8_BAR;
        PG8_WAIT_V(4); PG8_BAR;
        PG8_STAGE(PG8_SB(1, 0), cB + kstep, voffB); PG8_STAGE(PG8_SA(1, 0), cA + kstep, voffA); PG8_STAGE(PG8_SB(1, 1), cB + hstep + kstep, voffB);
        PG8_WAIT_V(6); PG8_BAR;
    }
    for (;;) {
        const bool has_next = S.next(ui + 1, nxt);
        const char* nA = has_next ? (const char*)(nxt.z ? g.A2 : g.A) + (size_t)nxt.pm * tstep : cA; const char* nB = has_next ? (const char*)(nxt.z ? g.Bt2 : g.Bt) + (size_t)nxt.pn * tstep : cB;
        for (int t = 0; t < nt; t += 2) {
            const bool last = (t == nt - 2);
            const char* a1 = cA + (size_t)(t + 1) * kstep;
            const char* a2 = last ? nA : cA + (size_t)(t + 2) * kstep; const char* b2 = last ? nB : cB + (size_t)(t + 2) * kstep;
            const char* a3 = a2 + kstep; const char* b3 = b2 + kstep;
            if (last && has_next) S.a_ready(nxt);
            if constexpr (SP2) {
            PG8_LDB(B0, 0, 0); PG8_LDB(B1, 0, 1); PG8_SCHED; PG8_LDA(At, 0, 0); PG8_STAGE(PG8_SA(1, 1), a1 + hstep, voffA);
            PG8_WAIT_V(8); PG8_WAIT_L(0); PG8_BAR; PG8_MMA(0, 0, At, B0); PG8_MMA(0, 1, At, B1); PG8_BAR; PG8_SCHED;
            PG8_LDA(At, 0, 1); PG8_STAGE(PG8_SB(0, 0), b2, voffB); PG8_STAGE(PG8_SB(0, 1), b2 + hstep, voffB); PG8_STAGE(PG8_SA(0, 0), a2, voffA);
            PG8_WAIT_V(8); PG8_WAIT_L(0); PG8_BAR; PG8_MMA(1, 0, At, B0); PG8_MMA(1, 1, At, B1); PG8_BAR; PG8_SCHED;
            PG8_LDB(B0, 1, 0); PG8_LDB(B1, 1, 1); PG8_SCHED; PG8_LDA(At, 1, 0); PG8_STAGE(PG8_SA(0, 1), a2 + hstep, voffA);
            PG8_WAIT_V(8); PG8_WAIT_L(0); PG8_BAR; PG8_MMA(0, 0, At, B0); PG8_MMA(0, 1, At, B1); PG8_BAR; PG8_SCHED;
            PG8_LDA(At, 1, 1); PG8_STAGE(PG8_SB(1, 0), b3, voffB); PG8_STAGE(PG8_SB(1, 1), b3 + hstep, voffB); PG8_STAGE(PG8_SA(1, 0), a3, voffA);
            PG8_WAIT_V(8); PG8_WAIT_L(0); PG8_BAR; PG8_MMA(1, 0, At, B0); PG8_MMA(1, 1, At, B1); PG8_BAR; PG8_SCHED;
            } else {
            PG8_LDB(B0, 0, 0); PG8_SCHED; PG8_LDA(At, 0, 0); PG8_STAGE(PG8_SA(1, 1), a1 + hstep, voffA);
            PG8_WAIT_L(8); PG8_BAR; PG8_WAIT_L(0); PG8_MMA(0, 0, At, B0); PG8_BAR; PG8_SCHED;
            PG8_LDB(B1, 0, 1); PG8_STAGE(PG8_SB(0, 0), b2, voffB);
            PG8_BAR; PG8_WAIT_L(0); PG8_MMA(0, 1, At, B1); PG8_BAR;
            PG8_LDA(At, 0, 1); PG8_STAGE(PG8_SA(0, 0), a2, voffA);
            PG8_BAR; PG8_WAIT_L(0); PG8_MMA(1, 0, At, B0); PG8_BAR; PG8_SCHED;
            PG8_STAGE(PG8_SB(0, 1), b2 + hstep, voffB);
            PG8_WAIT_V(6); PG8_BAR; PG8_MMA(1, 1, At, B1); PG8_BAR;
            PG8_LDB(B0, 1, 0); PG8_SCHED; PG8_LDA(At, 1, 0); PG8_STAGE(PG8_SA(0, 1), a2 + hstep, voffA);
            PG8_WAIT_L(8); PG8_BAR; PG8_WAIT_L(0); PG8_MMA(0, 0, At, B0); PG8_BAR; PG8_SCHED;
            PG8_LDB(B1, 1, 1); PG8_STAGE(PG8_SB(1, 0), b3, voffB);
            PG8_BAR; PG8_WAIT_L(0); PG8_MMA(0, 1, At, B1); PG8_BAR;
            PG8_LDA(At, 1, 1); PG8_STAGE(PG8_SA(1, 0), a3, voffA);
            PG8_BAR; PG8_WAIT_L(0); PG8_MMA(1, 0, At, B0); PG8_BAR; PG8_SCHED;
            PG8_STAGE(PG8_SB(1, 1), b3 + hstep, voffB);
            PG8_WAIT_V(6); PG8_BAR; PG8_MMA(1, 1, At, B1); PG8_BAR;
            }
        }
        if constexpr (ALIGN_EPI) { if (wr == 0) PG8_BAR; }
        if constexpr (!Epi::AFTER_DRAIN) { if constexpr (Epi::DUAL || Epi::MUT) E.dual(acc, cur, wr, wc, fr, fq); else E(acc, cur, wr, wc, fr, fq); S.done(cur); }
        if (!has_next) break;
        if (!(Epi::DUAL && cur.z == 0))
#pragma unroll
        for (int a = 0; a < 2; ++a)
#pragma unroll
            for (int b = 0; b < 2; ++b)
#pragma unroll
                for (int m = 0; m < 4; ++m)
#pragma unroll
                    for (int n = 0; n < 2; ++n) acc[a][b][m][n] = (f32x4){0.f, 0.f, 0.f, 0.f};
        cur = nxt; cA = nA; cB = nB; ++ui;
        if constexpr (ALIGN_EPI) { if (wr == 1) PG8_BAR; }
    }
    PG8_WAIT_V(0);
    if constexpr (!ALIGN_EPI) { if (wr == 0) PG8_BAR; }
    PG8_BAR;
    if constexpr (Epi::AFTER_DRAIN) { E.fused(acc, cur, wr, wc, fr, fq, lds, wid, lane); S.done(cur); }
#undef PG8_SA
#undef PG8_SB
#undef PG8_STAGE
#undef PG8_LDA
#undef PG8_LDB
#undef PG8_MMA
#undef PG8_WAIT_V
#undef PG8_WAIT_L
#undef PG8_BAR
#undef PG8_SCHED
}
}

#define LAS __attribute__((address_space(3)))
typedef unsigned short bf16;
typedef float f32x4 __attribute__((ext_vector_type(4)));
typedef float f32x2 __attribute__((ext_vector_type(2)));
typedef short bf16x8 __attribute__((ext_vector_type(8)));
typedef short s16x4 __attribute__((ext_vector_type(4)));
typedef unsigned u32x4 __attribute__((ext_vector_type(4)));
typedef unsigned u32x2 __attribute__((ext_vector_type(2)));

constexpr int DM = 2048, NB = 8, SEQ = 2048, MT = NB * SEQ, DIN = 16416, DFF = 8192, NMOD = 6 * DM;
constexpr int N1A = 12288, N1B = 4096;
constexpr float EPS = 1e-6f;
constexpr size_t MiB = 1u << 20;
constexpr size_t WS_MODP = 0, WS_WINLO = 12 * MiB, WS_OA = 0, WS_WINHI = 64 * MiB, WS_MOD = 80 * MiB, WS_SMALL = 81 * MiB, WS_CTL = 83 * MiB, WS_ROWSS = 83 * MiB + 65536, WS_PCNT = 83 * MiB + 196608, WS_ROWSS2 = 83 * MiB + 131072, WS_PCNT2 = 83 * MiB + 212992;
constexpr size_t WS_WA = 84 * MiB, WS_WB = 92 * MiB, WS_WO = 100 * MiB;
constexpr size_t WS_GQ = 108 * MiB, WS_GK = 140 * MiB, WS_GVT = 172 * MiB, WS_GG = 236 * MiB, WS_FQ = 300 * MiB, WS_FK = 364 * MiB, WS_FVT = 428 * MiB, WS_KDTG = 492 * MiB, WS_EBLG = 524 * MiB, WS_CUMG = 525 * MiB, WS_END = 526 * MiB;
constexpr size_t WS_SGA = 108 * MiB, WS_SGB = 300 * MiB, WS_W1 = 172 * MiB, WS_W2 = 204 * MiB, WS_T = 364 * MiB, WS_MG = 236 * MiB, WS_H2 = 108 * MiB, WS_U = 236 * MiB, WS_X2B = 108 * MiB, WS_X1B = 0;
constexpr int LDS_BYTES = 150 * 1024;

struct Args { const float* in[17]; float* out; unsigned char* ws; };

__device__ __forceinline__ unsigned f2bf(float f) { unsigned u = __builtin_bit_cast(unsigned, f); return (u + 0x7fffu + ((u >> 16) & 1u)) >> 16; }
typedef __bf16 bf16x2_t __attribute__((ext_vector_type(2)));
__device__ __forceinline__ unsigned pk2(float lo, float hi) { const f32x2 v = {lo, hi}; const bf16x2_t b = __builtin_convertvector(v, bf16x2_t); return __builtin_bit_cast(unsigned, b); }
__device__ __forceinline__ float bf2f(unsigned short v) { return __builtin_bit_cast(float, (unsigned)v << 16); }
__device__ __forceinline__ float bflo(unsigned w) { return __builtin_bit_cast(float, w << 16); }
__device__ __forceinline__ float bfhi(unsigned w) { return __builtin_bit_cast(float, w & 0xffff0000u); }
__device__ __forceinline__ float shx(float v, int o, int lane) { return __builtin_bit_cast(float, __builtin_amdgcn_ds_bpermute((lane ^ o) << 2, __builtin_bit_cast(int, v))); }
__device__ __forceinline__ float wave_sum(float v, int lane) {
#pragma unroll
    for (int o = 1; o < 64; o <<= 1) v += shx(v, o, lane);
    return v;
}
__device__ __forceinline__ float logsig(float z) { return fminf(z, 0.f) - __logf(1.f + __expf(-fabsf(z))); }
__device__ __forceinline__ float sigmoidf_(float z) { return __builtin_amdgcn_rcpf(1.f + __expf(-z)); }
template <int CTRL> __device__ __forceinline__ unsigned dppu(unsigned x) { return (unsigned)__builtin_amdgcn_mov_dpp((int)x, CTRL, 0xF, 0xF, true); }
template <int CTRL> __device__ __forceinline__ float dppx(float x) { return __builtin_bit_cast(float, __builtin_amdgcn_mov_dpp(__builtin_bit_cast(int, x), CTRL, 0xF, 0xF, true)); }
#define LDS_WAIT() asm volatile("s_waitcnt lgkmcnt(0)" ::: "memory")

struct EpiProj {
    static constexpr bool PERM = true, AFTER_DRAIN = false, DUAL = false, MUT = false;
    unsigned char* ws;
    __device__ __forceinline__ void operator()(const f32x4 (&acc)[2][2][4][2], const pg8::Unit& u, int wr, int wc, int fr, int fq) const {
        const int pn = u.pn, row0 = u.pm * 256 + wr * 64 + fr, cin = wc * 32 + 8 * fq;
        if (pn == 48) {
            if (wc == 0) { float* S = (float*)(ws + WS_SMALL);
#pragma unroll
                for (int ai = 0; ai < 2; ++ai)
#pragma unroll
                    for (int m = 0; m < 4; ++m) { float* p = S + (size_t)(row0 + ai * 128 + m * 16) * 32 + 8 * fq; *(f32x4*)p = acc[ai][0][m][0]; *(f32x4*)(p + 4) = acc[ai][0][m][1]; } }
            return;
        }
        const bool tr = (pn >= 8 && pn < 16) || pn >= 40;
        if (!tr) {
            bf16* base; int ld, c0;
            if (pn < 4) { base = (bf16*)(ws + WS_GQ); ld = 1024; c0 = pn * 256; }
            else if (pn < 8) { base = (bf16*)(ws + WS_GK); ld = 1024; c0 = (pn - 4) * 256; }
            else if (pn < 24) { base = (bf16*)(ws + WS_GG); ld = 2048; c0 = (pn - 16) * 256; }
            else if (pn < 32) { base = (bf16*)(ws + WS_FQ); ld = 2048; c0 = (pn - 24) * 256; }
            else { base = (bf16*)(ws + WS_FK); ld = 2048; c0 = (pn - 32) * 256; }
#pragma unroll
            for (int ai = 0; ai < 2; ++ai)
#pragma unroll
                for (int m = 0; m < 4; ++m) { bf16* rp = base + (size_t)(row0 + ai * 128 + m * 16) * ld + c0 + cin;
#pragma unroll
                    for (int bj = 0; bj < 2; ++bj) { const f32x4 v0 = acc[ai][bj][m][0], v1 = acc[ai][bj][m][1];
                        u32x4 w; w.x = pk2(v0[0], v0[1]); w.y = pk2(v0[2], v0[3]); w.z = pk2(v1[0], v1[1]); w.w = pk2(v1[2], v1[3]);
                        *(u32x4*)(rp + bj * 128) = w; } }
        } else {
            bf16* base = (bf16*)(ws + (pn < 16 ? WS_GVT : WS_FVT)); const int c0 = (pn < 16 ? pn - 8 : pn - 40) * 256;
            const int b = (u.pm * 256) / SEQ, blk0 = ((u.pm * 256) % SEQ) / 64 + wr, jq = fr & 3;
            const bool b0 = (jq & 1) != 0, b1 = (jq & 2) != 0;
            const int sn = 16 * jq + 4 * (fr >> 2); const int s = pn < 16 ? sn : ((sn & ~31) | (((sn >> 2) & 3) << 3) | (((sn >> 4) & 1) << 2));
            bf16* bb = base + (((size_t)b * 32 + blk0) * DM + c0 + cin) * 64 + s;
#pragma unroll
            for (int ai = 0; ai < 2; ++ai)
#pragma unroll
                for (int bj = 0; bj < 2; ++bj)
#pragma unroll
                    for (int n = 0; n < 2; ++n) { unsigned wx[4], wy[4];
#pragma unroll
                        for (int m = 0; m < 4; ++m) { float r0 = acc[ai][bj][m][n][0], r1 = acc[ai][bj][m][n][1], r2 = acc[ai][bj][m][n][2], r3 = acc[ai][bj][m][n][3];
                            { const float x = b0 ? r0 : r1, y = dppx<0xB1>(x); if (b0) r0 = y; else r1 = y; }
                            { const float x = b0 ? r2 : r3, y = dppx<0xB1>(x); if (b0) r2 = y; else r3 = y; }
                            { const float x = b1 ? r0 : r2, y = dppx<0x4E>(x); if (b1) r0 = y; else r2 = y; }
                            { const float x = b1 ? r1 : r3, y = dppx<0x4E>(x); if (b1) r1 = y; else r3 = y; }
                            wx[m] = pk2(r0, r1); wy[m] = pk2(r2, r3); }
                        { const unsigned x = b0 ? wx[0] : wx[1], y = dppu<0xB1>(x); if (b0) wx[0] = y; else wx[1] = y; }
                        { const unsigned x = b0 ? wx[2] : wx[3], y = dppu<0xB1>(x); if (b0) wx[2] = y; else wx[3] = y; }
                        { const unsigned x = b1 ? wx[0] : wx[2], y = dppu<0x4E>(x); if (b1) wx[0] = y; else wx[2] = y; }
                        { const unsigned x = b1 ? wx[1] : wx[3], y = dppu<0x4E>(x); if (b1) wx[1] = y; else wx[3] = y; }
                        { const unsigned x = b0 ? wy[0] : wy[1], y = dppu<0xB1>(x); if (b0) wy[0] = y; else wy[1] = y; }
                        { const unsigned x = b0 ? wy[2] : wy[3], y = dppu<0xB1>(x); if (b0) wy[2] = y; else wy[3] = y; }
                        { const unsigned x = b1 ? wy[0] : wy[2], y = dppu<0x4E>(x); if (b1) wy[0] = y; else wy[2] = y; }
                        { const unsigned x = b1 ? wy[1] : wy[3], y = dppu<0x4E>(x); if (b1) wy[1] = y; else wy[3] = y; }
#pragma unroll
                        for (int mc = 0; mc < 4; ++mc) { u32x2 w; w.x = wx[mc]; w.y = wy[mc];
                            *(u32x2*)(bb + ((size_t)(2 * ai) * DM + bj * 128 + 4 * n + mc) * 64) = w; } }
        }
    }
};
template <int MODE> struct EpiGen {
    static constexpr bool PERM = true, AFTER_DRAIN = false, DUAL = false, MUT = false;
    bf16* ob; int ldo; const bf16* gb; float* tf; const float* xin; float* xout; const float* gate;
    __device__ __forceinline__ void operator()(const f32x4 (&acc)[2][2][4][2], const pg8::Unit& u, int wr, int wc, int fr, int fq) const {
        const int row0 = u.pm * 256 + wr * 64 + fr; int col0 = u.pn * 256 + wc * 32 + 8 * fq;
        bf16* obase = ob;
        if (MODE == 0) { if (u.pn >= 8) { obase = (bf16*)((unsigned char*)ob + (WS_SGB - WS_SGA)); col0 -= 2048; } }
        f32x4 g0[2], g1[2];
        if (MODE == 3 || MODE == 5 || MODE == 6) { const float* gp = gate + (size_t)((u.pm * 256) / SEQ) * NMOD + col0;
#pragma unroll
            for (int bj = 0; bj < 2; ++bj) { g0[bj] = *(const f32x4*)(gp + bj * 128); g1[bj] = *(const f32x4*)(gp + bj * 128 + 4); } }
#pragma unroll
        for (int aq = 0; aq < 4; ++aq) { const int ai = aq >> 1, mh = aq & 1;
            u32x4 gw[2][2]; f32x4 p0[2][2], p1[2][2];
            if (MODE == 1 || MODE == 2 || MODE == 3 || MODE == 5 || MODE == 6) {
#pragma unroll
                for (int m2 = 0; m2 < 2; ++m2) { const size_t row = (size_t)(row0 + ai * 128 + (2 * mh + m2) * 16);
#pragma unroll
                    for (int bj = 0; bj < 2; ++bj) { const int col = col0 + bj * 128;
                        if (MODE == 1 || MODE == 2 || MODE == 6) gw[m2][bj] = *(const u32x4*)(gb + row * 2048 + col);
                        if (MODE == 2) { p0[m2][bj] = *(const f32x4*)(tf + row * 2048 + col); p1[m2][bj] = *(const f32x4*)(tf + row * 2048 + col + 4); }
                        if (MODE == 3 || MODE == 5) { p0[m2][bj] = *(const f32x4*)(xin + row * 2048 + col); p1[m2][bj] = *(const f32x4*)(xin + row * 2048 + col + 4); } } }
                __builtin_amdgcn_sched_barrier(0); }
#pragma unroll
            for (int m2 = 0; m2 < 2; ++m2) { const int m = 2 * mh + m2; const size_t row = (size_t)(row0 + ai * 128 + m * 16);
#pragma unroll
                for (int bj = 0; bj < 2; ++bj) { f32x4 v0 = acc[ai][bj][m][0], v1 = acc[ai][bj][m][1]; const int col = col0 + bj * 128;
                    if (MODE == 0) {
#pragma unroll
                        for (int e = 0; e < 4; ++e) { v0[e] = sigmoidf_(v0[e]); v1[e] = sigmoidf_(v1[e]); }
                        u32x4 w; w.x = pk2(v0[0], v0[1]); w.y = pk2(v0[2], v0[3]); w.z = pk2(v1[0], v1[1]); w.w = pk2(v1[2], v1[3]);
                        *(u32x4*)(obase + row * ldo + col) = w;
                    } else if (MODE == 1 || MODE == 2) {
                        const u32x4 g = gw[m2][bj];
                        const f32x4 s0 = {bflo(g.x), bfhi(g.x), bflo(g.y), bfhi(g.y)}, s1 = {bflo(g.z), bfhi(g.z), bflo(g.w), bfhi(g.w)};
                        float* tp = tf + row * 2048 + col;
                        if (MODE == 1) { *(f32x4*)tp = s0 * v0; *(f32x4*)(tp + 4) = s1 * v1; }
                        else { v0 = p0[m2][bj] + s0 * v0; v1 = p1[m2][bj] + s1 * v1;
                            u32x4 w; w.x = pk2(v0[0], v0[1]); w.y = pk2(v0[2], v0[3]); w.z = pk2(v1[0], v1[1]); w.w = pk2(v1[2], v1[3]);
                            *(u32x4*)(obase + row * ldo + col) = w; }
                    } else if (MODE == 3) {
                        float* op = xout + row * 2048 + col;
                        *(f32x4*)op = p0[m2][bj] + g0[bj] * v0; *(f32x4*)(op + 4) = p1[m2][bj] + g1[bj] * v1;
                    } else if (MODE == 5 || MODE == 6) {
                        f32x4 x0, x1;
                        if (MODE == 5) { x0 = p0[m2][bj]; x1 = p1[m2][bj]; }
                        else { const u32x4 g = gw[m2][bj]; x0 = (f32x4){bflo(g.x), bfhi(g.x), bflo(g.y), bfhi(g.y)}; x1 = (f32x4){bflo(g.z), bfhi(g.z), bflo(g.w), bfhi(g.w)}; }
                        v0 = x0 + g0[bj] * v0; v1 = x1 + g1[bj] * v1;
                        u32x4 w; w.x = pk2(v0[0], v0[1]); w.y = pk2(v0[2], v0[3]); w.z = pk2(v1[0], v1[1]); w.w = pk2(v1[2], v1[3]);
                        *(u32x4*)(obase + row * ldo + col) = w;
                    } else {
#pragma unroll
                        for (int e = 0; e < 4; ++e) { const float a = fmaxf(v0[e], 0.f), c = fmaxf(v1[e], 0.f); v0[e] = a * a; v1[e] = c * c; }
                        u32x4 w; w.x = pk2(v0[0], v0[1]); w.y = pk2(v0[2], v0[3]); w.z = pk2(v1[0], v1[1]); w.w = pk2(v1[2], v1[3]);
                        *(u32x4*)(obase + row * ldo + col) = w;
                    } } }
            if (MODE == 1 || MODE == 2 || MODE == 3 || MODE == 5 || MODE == 6) __builtin_amdgcn_sched_barrier(0); }
    }
};

struct EpiDual {
    static constexpr bool PERM = true, AFTER_DRAIN = false, DUAL = true, MUT = false;
    bf16* mg; const bf16* sga; const bf16* sgb;
    __device__ __forceinline__ void dual(f32x4 (&acc)[2][2][4][2], const pg8::Unit& u, int wr, int wc, int fr, int fq) const {
        const int row0 = u.pm * 256 + wr * 64 + fr, col0 = u.pn * 256 + wc * 32 + 8 * fq; const bool first = (u.z == 0);
#pragma unroll
        for (int aq = 0; aq < 4; ++aq) { const int ai = aq >> 1, mh = aq & 1;
            u32x4 ga[2][2], gbv[2][2];
#pragma unroll
            for (int m2 = 0; m2 < 2; ++m2) { const size_t row = (size_t)(row0 + ai * 128 + (2 * mh + m2) * 16);
#pragma unroll
                for (int bj = 0; bj < 2; ++bj) { const int col = col0 + bj * 128; gbv[m2][bj] = *(const u32x4*)(sgb + row * 2048 + col); if (first) ga[m2][bj] = *(const u32x4*)(sga + row * 2048 + col); else ga[m2][bj] = (u32x4){0u, 0u, 0u, 0u}; } }
            __builtin_amdgcn_sched_barrier(0);
#pragma unroll
            for (int m2 = 0; m2 < 2; ++m2) { const int m = 2 * mh + m2; const size_t row = (size_t)(row0 + ai * 128 + m * 16);
#pragma unroll
                for (int bj = 0; bj < 2; ++bj) { const u32x4 gB = gbv[m2][bj], gA = ga[m2][bj]; const int col = col0 + bj * 128;
                    f32x4 b0 = {bflo(gB.x), bfhi(gB.x), bflo(gB.y), bfhi(gB.y)}, b1 = {bflo(gB.z), bfhi(gB.z), bflo(gB.w), bfhi(gB.w)};
#pragma unroll
                    for (int e = 0; e < 4; ++e) { b0[e] = fmaxf(b0[e], 1e-30f); b1[e] = fmaxf(b1[e], 1e-30f); }
                    if (first) {
                        const f32x4 a0 = {bflo(gA.x), bfhi(gA.x), bflo(gA.y), bfhi(gA.y)}, a1 = {bflo(gA.z), bfhi(gA.z), bflo(gA.w), bfhi(gA.w)};
#pragma unroll
                        for (int e = 0; e < 4; ++e) { acc[ai][bj][m][0][e] *= a0[e] / b0[e]; acc[ai][bj][m][1][e] *= a1[e] / b1[e]; }
                    } else {
                        const f32x4 v0 = acc[ai][bj][m][0] * b0, v1 = acc[ai][bj][m][1] * b1;
                        u32x4 w; w.x = pk2(v0[0], v0[1]); w.y = pk2(v0[2], v0[3]); w.z = pk2(v1[0], v1[1]); w.w = pk2(v1[2], v1[3]);
                        *(u32x4*)(mg + row * 2048 + col) = w; } } }
            __builtin_amdgcn_sched_barrier(0); }
    }
    __device__ __forceinline__ void operator()(const f32x4 (&)[2][2][4][2], const pg8::Unit&, int, int, int, int) const {}
};

struct EpiFinal {
    static constexpr bool PERM = true, AFTER_DRAIN = false, DUAL = false, MUT = true;
    float* out; const bf16* x1b; const float* gate; const float* gfin; float* rowss; unsigned* pcnt; LAS float* scr;
    __device__ __forceinline__ void dual(f32x4 (&acc)[2][2][4][2], const pg8::Unit& u, int wr, int wc, int fr, int fq) const {
        const int row0 = u.pm * 256 + wr * 64 + fr, col0 = u.pn * 256 + wc * 32 + 8 * fq, lane = fr + 16 * fq;
        f32x4 g0[2], g1[2];
        { const float* gp = gate + (size_t)((u.pm * 256) / SEQ) * NMOD + col0;
#pragma unroll
          for (int bj = 0; bj < 2; ++bj) { g0[bj] = *(const f32x4*)(gp + bj * 128); g1[bj] = *(const f32x4*)(gp + bj * 128 + 4); } }
        float ssq[2][4];
#pragma unroll
        for (int aq = 0; aq < 4; ++aq) { const int ai = aq >> 1, mh = aq & 1; u32x4 gw[2][2];
#pragma unroll
            for (int m2 = 0; m2 < 2; ++m2)
#pragma unroll
                for (int bj = 0; bj < 2; ++bj) gw[m2][bj] = *(const u32x4*)(x1b + (size_t)(row0 + ai * 128 + (2 * mh + m2) * 16) * 2048 + col0 + bj * 128);
            __builtin_amdgcn_sched_barrier(0);
#pragma unroll
            for (int m2 = 0; m2 < 2; ++m2) { const int m = 2 * mh + m2; float ss = 0.f;
#pragma unroll
                for (int bj = 0; bj < 2; ++bj) { const u32x4 g = gw[m2][bj];
                    const f32x4 x0 = {bflo(g.x), bfhi(g.x), bflo(g.y), bfhi(g.y)}, x1 = {bflo(g.z), bfhi(g.z), bflo(g.w), bfhi(g.w)};
                    const f32x4 v0 = x0 + g0[bj] * acc[ai][bj][m][0], v1 = x1 + g1[bj] * acc[ai][bj][m][1];
                    acc[ai][bj][m][0] = v0; acc[ai][bj][m][1] = v1;
                    ss += (v0[0] * v0[0] + v0[1] * v0[1]) + (v0[2] * v0[2] + v0[3] * v0[3]) + (v1[0] * v1[0] + v1[1] * v1[1]) + (v1[2] * v1[2] + v1[3] * v1[3]); }
                ss += shx(ss, 16, lane); ss += shx(ss, 32, lane); ssq[ai][m] = ss; }
            __builtin_amdgcn_sched_barrier(0); }
        if (fq == 0) {
#pragma unroll
            for (int ai = 0; ai < 2; ++ai)
#pragma unroll
                for (int m = 0; m < 4; ++m) scr[(wr * 64 + ai * 128 + m * 16 + fr) * 4 + wc] = ssq[ai][m]; }
        asm volatile("s_waitcnt lgkmcnt(0)" ::: "memory"); __builtin_amdgcn_s_barrier(); asm volatile("" ::: "memory");
        const int tid = (wr * 4 + wc) * 64 + lane;
        if (tid < 256) { const f32x4 q4 = *(const LAS f32x4*)(scr + tid * 4);
            __hip_atomic_fetch_add(rowss + u.pm * 256 + tid, (q4[0] + q4[1]) + (q4[2] + q4[3]), __ATOMIC_RELAXED, __HIP_MEMORY_SCOPE_AGENT); }
        asm volatile("s_waitcnt vmcnt(0) lgkmcnt(0)" ::: "memory"); __builtin_amdgcn_s_barrier(); asm volatile("" ::: "memory");
        unsigned* pc = pcnt + 64 * u.pm;
        if (tid == 0) __hip_atomic_fetch_add(pc, 1u, __ATOMIC_RELAXED, __HIP_MEMORY_SCOPE_AGENT);
        { unsigned spins = 0; while (__hip_atomic_load(pc, __ATOMIC_RELAXED, __HIP_MEMORY_SCOPE_AGENT) < 8u) { __builtin_amdgcn_s_sleep(2); if (++spins > (1u << 20)) break; } }
        asm volatile("" ::: "memory");
#pragma unroll
        for (int ai = 0; ai < 2; ++ai)
#pragma unroll
            for (int m = 0; m < 4; ++m) { const size_t row = (size_t)(row0 + ai * 128 + m * 16);
                const float tot = __hip_atomic_load(rowss + row, __ATOMIC_RELAXED, __HIP_MEMORY_SCOPE_AGENT);
                const float rstd = rsqrtf(tot * (1.f / DM) + EPS);
#pragma unroll
                for (int bj = 0; bj < 2; ++bj) { const int col = col0 + bj * 128; const f32x4 f0 = *(const f32x4*)(gfin + col), f1 = *(const f32x4*)(gfin + col + 4);
                    float* op = out + row * 2048 + col;
                    *(f32x4*)op = acc[ai][bj][m][0] * rstd * f0; *(f32x4*)(op + 4) = acc[ai][bj][m][1] * rstd * f1; } }
    }
    __device__ __forceinline__ void operator()(const f32x4 (&)[2][2][4][2], const pg8::Unit&, int, int, int, int) const {}
};
struct EpiMid {
    static constexpr bool PERM = true, AFTER_DRAIN = false, DUAL = false, MUT = true;
    bf16* x1b; bf16* h2; const float* xin; const float* mod; const float* g2; float* rowss; unsigned* pcnt; LAS float* scr;
    __device__ __forceinline__ void dual(f32x4 (&acc)[2][2][4][2], const pg8::Unit& u, int wr, int wc, int fr, int fq) const {
        const int row0 = u.pm * 256 + wr * 64 + fr, col0 = u.pn * 256 + wc * 32 + 8 * fq, lane = fr + 16 * fq;
        const float* mb = mod + (size_t)((u.pm * 256) / SEQ) * NMOD;
        f32x4 g0[2], g1[2];
#pragma unroll
        for (int bj = 0; bj < 2; ++bj) { g0[bj] = *(const f32x4*)(mb + 2 * DM + col0 + bj * 128); g1[bj] = *(const f32x4*)(mb + 2 * DM + col0 + bj * 128 + 4); }
        float ssq[2][4];
#pragma unroll
        for (int aq = 0; aq < 4; ++aq) { const int ai = aq >> 1, mh = aq & 1; f32x4 p0[2][2], p1[2][2];
#pragma unroll
            for (int m2 = 0; m2 < 2; ++m2)
#pragma unroll
                for (int bj = 0; bj < 2; ++bj) { const float* xp = xin + (size_t)(row0 + ai * 128 + (2 * mh + m2) * 16) * 2048 + col0 + bj * 128; p0[m2][bj] = *(const f32x4*)xp; p1[m2][bj] = *(const f32x4*)(xp + 4); }
            __builtin_amdgcn_sched_barrier(0);
#pragma unroll
            for (int m2 = 0; m2 < 2; ++m2) { const int m = 2 * mh + m2; float ss = 0.f; const size_t row = (size_t)(row0 + ai * 128 + m * 16);
#pragma unroll
                for (int bj = 0; bj < 2; ++bj) {
                    const f32x4 v0 = p0[m2][bj] + g0[bj] * acc[ai][bj][m][0], v1 = p1[m2][bj] + g1[bj] * acc[ai][bj][m][1];
                    acc[ai][bj][m][0] = v0; acc[ai][bj][m][1] = v1;
                    ss += (v0[0] * v0[0] + v0[1] * v0[1]) + (v0[2] * v0[2] + v0[3] * v0[3]) + (v1[0] * v1[0] + v1[1] * v1[1]) + (v1[2] * v1[2] + v1[3] * v1[3]);
                    u32x4 w; w.x = pk2(v0[0], v0[1]); w.y = pk2(v0[2], v0[3]); w.z = pk2(v1[0], v1[1]); w.w = pk2(v1[2], v1[3]);
                    *(u32x4*)(x1b + row * 2048 + col0 + bj * 128) = w; }
                ss += shx(ss, 16, lane); ss += shx(ss, 32, lane); ssq[ai][m] = ss; }
            __builtin_amdgcn_sched_barrier(0); }
        if (fq == 0) {
#pragma unroll
            for (int ai = 0; ai < 2; ++ai)
#pragma unroll
                for (int m = 0; m < 4; ++m) scr[(wr * 64 + ai * 128 + m * 16 + fr) * 4 + wc] = ssq[ai][m]; }
        asm volatile("s_waitcnt lgkmcnt(0)" ::: "memory"); __builtin_amdgcn_s_barrier(); asm volatile("" ::: "memory");
        const int tid = (wr * 4 + wc) * 64 + lane;
        if (tid < 256) { const f32x4 q4 = *(const LAS f32x4*)(scr + tid * 4);
            __hip_atomic_fetch_add(rowss + u.pm * 256 + tid, (q4[0] + q4[1]) + (q4[2] + q4[3]), __ATOMIC_RELAXED, __HIP_MEMORY_SCOPE_AGENT); }
        asm volatile("s_waitcnt vmcnt(0) lgkmcnt(0)" ::: "memory"); __builtin_amdgcn_s_barrier(); asm volatile("" ::: "memory");
        unsigned* pc = pcnt + 64 * u.pm;
        if (tid == 0) __hip_atomic_fetch_add(pc, 1u, __ATOMIC_RELAXED, __HIP_MEMORY_SCOPE_AGENT);
        { unsigned spins = 0; while (__hip_atomic_load(pc, __ATOMIC_RELAXED, __HIP_MEMORY_SCOPE_AGENT) < 8u) { __builtin_amdgcn_s_sleep(2); if (++spins > (1u << 20)) break; } }
        asm volatile("" ::: "memory");
        float rs[2][4];
#pragma unroll
        for (int ai = 0; ai < 2; ++ai)
#pragma unroll
            for (int m = 0; m < 4; ++m) rs[ai][m] = rsqrtf(__hip_atomic_load(rowss + row0 + ai * 128 + m * 16, __ATOMIC_RELAXED, __HIP_MEMORY_SCOPE_AGENT) * (1.f / DM) + EPS);
#pragma unroll
        for (int bj = 0; bj < 2; ++bj) { const int col = col0 + bj * 128;
            const f32x4 ga = *(const f32x4*)(g2 + col), gb2 = *(const f32x4*)(g2 + col + 4);
            f32x4 sa = *(const f32x4*)(mb + 4 * DM + col), sb = *(const f32x4*)(mb + 4 * DM + col + 4); const f32x4 ha = *(const f32x4*)(mb + 3 * DM + col), hb = *(const f32x4*)(mb + 3 * DM + col + 4);
            sa = (sa + 1.f) * ga; sb = (sb + 1.f) * gb2;
#pragma unroll
            for (int ai = 0; ai < 2; ++ai)
#pragma unroll
                for (int m = 0; m < 4; ++m) { const size_t row = (size_t)(row0 + ai * 128 + m * 16); const float r = rs[ai][m];
                    const f32x4 o0 = acc[ai][bj][m][0] * r * sa + ha, o1 = acc[ai][bj][m][1] * r * sb + hb;
                    u32x4 w; w.x = pk2(o0[0], o0[1]); w.y = pk2(o0[2], o0[3]); w.z = pk2(o1[0], o1[1]); w.w = pk2(o1[2], o1[3]);
                    *(u32x4*)(h2 + row * 2048 + col) = w; } }
    }
    __device__ __forceinline__ void operator()(const f32x4 (&)[2][2][4][2], const pg8::Unit&, int, int, int, int) const {}
};
__device__ __forceinline__ int my_lane() { int l; asm volatile("v_mbcnt_lo_u32_b32 %0, -1, 0\n\tv_mbcnt_hi_u32_b32 %0, -1, %0" : "=v"(l)); return l; }

__device__ __forceinline__ void tr_item(const float* W, int ldw, int k0, int srccol, bf16* WT, int K, int dstrow0, LAS float* scr, int lane) {
    const int kr = lane >> 4, c4 = lane & 15;
    f32x4 v[16];
#pragma unroll
    for (int i = 0; i < 16; ++i) v[i] = srccol >= 0 ? *(const f32x4*)(W + (size_t)(k0 + kr + 4 * i) * ldw + srccol) : (f32x4){0.f, 0.f, 0.f, 0.f};
#pragma unroll
    for (int i = 0; i < 16; ++i) { LAS float* p = scr + (kr + 4 * i) * 65 + 4 * c4; p[0] = v[i][0]; p[1] = v[i][1]; p[2] = v[i][2]; p[3] = v[i][3]; }
    LDS_WAIT(); asm volatile("" ::: "memory");
    const int c = lane & 7;
#pragma unroll
    for (int j = 0; j < 8; ++j) { const int n = (lane >> 3) + 8 * j; const LAS float* s = scr + (8 * c) * 65 + n;
        u32x4 o; o.x = pk2(s[0 * 65], s[1 * 65]); o.y = pk2(s[2 * 65], s[3 * 65]); o.z = pk2(s[4 * 65], s[5 * 65]); o.w = pk2(s[6 * 65], s[7 * 65]);
        *(u32x4*)(WT + (size_t)(dstrow0 + n) * K + k0 + 8 * c) = o; }
    LDS_WAIT(); asm volatile("" ::: "memory");
}
__device__ __forceinline__ void tr_plain(const float* W, int K, int N, bf16* WT, int item, LAS float* scr, int lane) {
    const int nblk = N / 64, kb = item / nblk, nb = item % nblk;
    tr_item(W, N, 64 * kb, 64 * nb + 4 * (lane & 15), WT, K, 64 * nb, scr, lane);
}
__device__ __forceinline__ void p0_phase(const Args& a, LAS unsigned char* lds, int gw, int NGW, int wave, int lane) {
    LAS float* scr = (LAS float*)(lds + wave * 16896);
    unsigned char* ws = a.ws;
    constexpr int NDB = 193 + 64, I_IN = 32 * NDB, I_SQ = 32 * 32;
    for (int it = gw; it < I_IN + 3 * I_SQ; it += NGW) {
        if (it < I_IN) {
            const int kb = it / NDB, db = it % NDB;
            int dstrow0; bf16* WT;
            if (db < 193) { dstrow0 = 64 * db; WT = (bf16*)(ws + WS_WINLO); } else { dstrow0 = 64 * (db - 193); WT = (bf16*)(ws + WS_WINHI); }
            const int d = (db < 193 ? 64 * db : 12544 + 64 * (db - 193)) + 4 * (lane & 15);
            int src;
            if (d < 6144) src = d; else if (d < 12288) src = d + 16; else if (d < 12304) src = 6144 + (d - 12288); else if (d < 12320) src = d; else if (d < 12544) src = -1; else src = d - 224;
            tr_item(a.in[5], DIN, 64 * kb, src, WT, DM, dstrow0, scr, lane);
        } else {
            int r = it - I_IN;
            if (r < I_SQ) tr_plain(a.in[10], DM, DM, (bf16*)(ws + WS_WA), r, scr, lane);
            else if (r < 2 * I_SQ) tr_plain(a.in[11], DM, DM, (bf16*)(ws + WS_WB), r - I_SQ, scr, lane);
            else tr_plain(a.in[12], DM, DM, (bf16*)(ws + WS_WO), r - 2 * I_SQ, scr, lane);
        }
    }
    { u32x4* z = (u32x4*)(ws + WS_WINLO + (size_t)12352 * DM * 2); const int n16 = 192 * DM * 2 / 16;
      for (int i = gw * 64 + lane; i < n16; i += NGW * 64) z[i] = (u32x4){0u, 0u, 0u, 0u}; }
    const float* c = a.in[1]; const float* wada = a.in[2]; float* modp = (float*)(ws + WS_MODP);
    for (int it = gw; it < 32 * 48; it += NGW) {
        const int kc = it / 48, nb = it % 48, k0 = kc * 64;
#pragma unroll
        for (int b = 0; b < 8; ++b) { const float v = c[b * DM + k0 + lane]; scr[b * 64 + lane] = v * sigmoidf_(v); }
        LDS_WAIT(); asm volatile("" ::: "memory");
        f32x4 acc[8];
#pragma unroll
        for (int b = 0; b < 8; ++b) acc[b] = (f32x4){0.f, 0.f, 0.f, 0.f};
        const float* wp = wada + (size_t)k0 * NMOD + nb * 256 + lane * 4;
#pragma unroll 8
        for (int kk = 0; kk < 64; ++kk) { const f32x4 w = *(const f32x4*)(wp + (size_t)kk * NMOD);
#pragma unroll
            for (int b = 0; b < 8; ++b) acc[b] += w * scr[b * 64 + kk]; }
#pragma unroll
        for (int b = 0; b < 8; ++b) *(f32x4*)(modp + (size_t)(kc * 8 + b) * NMOD + nb * 256 + lane * 4) = acc[b];
        LDS_WAIT(); asm volatile("" ::: "memory");
    }
}

struct RowRegs { f32x4 v[8]; };
__device__ __forceinline__ void row_load(RowRegs& R, const float* xrow, int lane) {
#pragma unroll
    for (int j = 0; j < 8; ++j) R.v[j] = *(const f32x4*)(xrow + (j * 64 + lane) * 4);
}
__device__ __forceinline__ void row_load_b16(RowRegs& R, const bf16* xrow, int lane) {
#pragma unroll
    for (int j = 0; j < 4; ++j) { const u32x4 w = *(const u32x4*)(xrow + (j * 64 + lane) * 8);
        R.v[2 * j] = (f32x4){bflo(w.x), bfhi(w.x), bflo(w.y), bfhi(w.y)}; R.v[2 * j + 1] = (f32x4){bflo(w.z), bfhi(w.z), bflo(w.w), bfhi(w.w)}; }
}
template <bool SRC16> __device__ __forceinline__ int row_col(int j, int lane) { return SRC16 ? ((j >> 1) * 64 + lane) * 8 + (j & 1) * 4 : (j * 64 + lane) * 4; }
template <class SC, bool SRC16 = false>
__device__ __forceinline__ void norm_finish_bf16(const RowRegs& R, const float* g, SC scp, SC shp, bf16* orow, int lane) {
    float ss = 0.f;
#pragma unroll
    for (int j = 0; j < 8; ++j) ss += (R.v[j][0] * R.v[j][0] + R.v[j][1] * R.v[j][1]) + (R.v[j][2] * R.v[j][2] + R.v[j][3] * R.v[j][3]);
    const float rstd = rsqrtf(wave_sum(ss, lane) * (1.f / DM) + EPS);
#pragma unroll
    for (int j = 0; j < 8; ++j) { const int col = row_col<SRC16>(j, lane); const f32x4 gg = *(const f32x4*)(g + col);
        float o[4];
#pragma unroll
        for (int e = 0; e < 4; ++e) o[e] = R.v[j][e] * rstd * gg[e] * (1.f + scp[col + e]) + shp[col + e];
        u32x2 w; w.x = pk2(o[0], o[1]); w.y = pk2(o[2], o[3]); *(u32x2*)(orow + col) = w; }
}
__device__ __forceinline__ void p1_phase(const Args& a, LAS unsigned char* lds, int tid, int wave, int lane) {
    unsigned char* ws = a.ws; const float* modp = (const float*)(ws + WS_MODP); const float* bada = a.in[3]; float* mod = (float*)(ws + WS_MOD);
    const int G = gridDim.x;
    for (int o = blockIdx.x * 512 + tid; o < 8 * NMOD; o += G * 512) { float s = bada[o % NMOD];
#pragma unroll 8
        for (int kc = 0; kc < 32; ++kc) s += modp[(size_t)kc * 8 * NMOD + o];
        mod[o] = s; }
    LAS float* ml = (LAS float*)lds;
    bf16* H = (bf16*)a.out;
    for (int it = blockIdx.x; it < MT / 64; it += G) {
        const int b = it / 32;
        __syncthreads();
        for (int o = tid; o < 4096; o += 512) { float s = bada[o];
#pragma unroll 8
            for (int kc = 0; kc < 32; ++kc) s += modp[(size_t)(kc * 8 + b) * NMOD + o];
            ml[o] = s; }
        __syncthreads();
        for (int r = 0; r < 8; r += 2) { const int row = it * 64 + wave * 8 + r; RowRegs R0, R1;
            row_load(R0, a.in[0] + (size_t)row * DM, lane); row_load(R1, a.in[0] + (size_t)(row + 1) * DM, lane);
            norm_finish_bf16<const LAS float*>(R0, a.in[4], ml + 2048, ml, H + (size_t)row * DM, lane);
            norm_finish_bf16<const LAS float*>(R1, a.in[4], ml + 2048, ml, H + (size_t)(row + 1) * DM, lane); }
        __syncthreads();
        { const int rt = wave >> 1, ct = wave & 1, fr = lane & 15, quad = lane >> 4;
          const bf16* ap = H + (size_t)(it * 64 + rt * 16 + fr) * DM + quad * 8; const bf16* bp = (const bf16*)(ws + WS_WINLO) + (size_t)(12288 + ct * 16 + fr) * DM + quad * 8;
          f32x4 acc0 = {0.f, 0.f, 0.f, 0.f}, acc1 = {0.f, 0.f, 0.f, 0.f};
          for (int k0 = 0; k0 < 64; k0 += 8) { bf16x8 av[8], bv[8];
#pragma unroll
              for (int k = 0; k < 8; ++k) { av[k] = *(const bf16x8*)(ap + (k0 + k) * 32); bv[k] = *(const bf16x8*)(bp + (k0 + k) * 32); }
#pragma unroll
              for (int k = 0; k < 8; k += 2) { acc0 = __builtin_amdgcn_mfma_f32_16x16x32_bf16(av[k], bv[k], acc0, 0, 0, 0); acc1 = __builtin_amdgcn_mfma_f32_16x16x32_bf16(av[k + 1], bv[k + 1], acc1, 0, 0, 0); } }
          acc0 = acc0 + acc1; float* sp = (float*)(ws + WS_SMALL) + (size_t)(it * 64 + rt * 16 + quad * 4) * 32 + ct * 16 + fr;
#pragma unroll
          for (int i = 0; i < 4; ++i) sp[i * 32] = acc0[i]; }
    }
    __syncthreads();
}

#define LBAR() do { asm volatile("s_waitcnt lgkmcnt(0)" ::: "memory"); __builtin_amdgcn_s_barrier(); asm volatile("" ::: "memory"); } while (0)
#define MFMA16(a_, b_, c_) __builtin_amdgcn_mfma_f32_16x16x32_bf16((a_), (b_), (c_), 0, 0, 0)
__device__ __forceinline__ void gla_prep_unit(const Args& a, LAS unsigned char* lds, int unit, int tid) {
    unsigned char* ws = a.ws;
    const int b = unit >> 7, h = (unit >> 5) & 3, c = unit & 31, R0 = b * SEQ + c * 64;
    LAS float* GA = (LAS float*)lds; LAS float* HT = (LAS float*)(lds + 4096); LAS float* BLR = (LAS float*)(lds + 5120);
    const int dk = tid & 255, half = tid >> 8;
    const float* wup = a.in[6]; float wu[16];
#pragma unroll
    for (int r = 0; r < 16; ++r) wu[r] = wup[r * 1024 + h * 256 + dk];
    const float ba = a.in[7][h * 256 + dk];
    bf16* GQ = (bf16*)(ws + WS_GQ); bf16* GK = (bf16*)(ws + WS_GK); const float* SMALL = (const float*)(ws + WS_SMALL);
    __syncthreads();
    { const f32x2 g2 = *(const f32x2*)(SMALL + (size_t)(R0 + (tid >> 3)) * 32 + (tid & 7) * 2); *(LAS f32x2*)(GA + (tid >> 3) * 16 + (tid & 7) * 2) = g2; }
    bf16* qp = GQ + (size_t)(R0 + half * 32) * 1024 + h * 256 + dk; bf16* kp = GK + (size_t)(R0 + half * 32) * 1024 + h * 256 + dk;
    __syncthreads();
    float bc[32]; float run = 0.f;
#pragma unroll
    for (int tt = 0; tt < 32; ++tt) { const int t = half * 32 + tt; float z = ba;
#pragma unroll
        for (int r4 = 0; r4 < 4; ++r4) { const f32x4 g = *(const LAS f32x4*)(GA + t * 16 + r4 * 4); z += g[0] * wu[r4 * 4] + g[1] * wu[r4 * 4 + 1] + g[2] * wu[r4 * 4 + 2] + g[3] * wu[r4 * 4 + 3]; }
        run += logsig(z) * 0.0625f; bc[tt] = run; }
    if (half == 0) HT[dk] = run;
    __syncthreads();
    if (half == 1) { const float add = HT[dk];
#pragma unroll
        for (int tt = 0; tt < 32; ++tt) bc[tt] += add;
        BLR[dk] = bc[31]; ((float*)(ws + WS_EBLG))[(size_t)unit * 256 + dk] = __expf(bc[31]); }
    __syncthreads();
    const float bl = BLR[dk];
    bf16* kdt = (bf16*)(ws + WS_KDTG) + ((size_t)unit * 256 + dk) * 64 + half * 32;
    float qv[32], kv[32];
#pragma unroll
    for (int tt = 0; tt < 32; ++tt) { qv[tt] = bf2f(qp[(size_t)tt * 1024]); kv[tt] = bf2f(kp[(size_t)tt * 1024]); }
    __syncthreads();
    const int dkp = (dk & ~31) | (((dk >> 2) & 3) << 3) | (((dk >> 4) & 1) << 2) | (dk & 3);
    bf16* qw = qp - dk + dkp; bf16* kw = kp - dk + dkp;
#pragma unroll
    for (int t8 = 0; t8 < 4; ++t8) { float kd[8];
#pragma unroll
        for (int e = 0; e < 8; ++e) { const int tt = t8 * 8 + e;
            qw[(size_t)tt * 1024] = (bf16)f2bf(qv[tt] * __expf(bc[tt]) * 0.0625f);
            kw[(size_t)tt * 1024] = (bf16)f2bf(kv[tt] * __expf(-bc[tt]));
            kd[e] = kv[tt] * __expf(bl - bc[tt]); }
        u32x4 w; w.x = pk2(kd[0], kd[1]); w.y = pk2(kd[2], kd[3]); w.z = pk2(kd[4], kd[5]); w.w = pk2(kd[6], kd[7]);
        *(u32x4*)(kdt + t8 * 8) = w; }
}
__device__ __forceinline__ void cum_item(const Args& a, LAS unsigned char* lds, int item, int tid, int wave, int lane) {
    unsigned char* ws = a.ws; const int b = item >> 4, h = item & 15; LAS float* WTOT = (LAS float*)lds; const float* SMALL = (const float*)(ws + WS_SMALL);
    const float bf_ = a.in[9][h]; float p[4]; float run = 0.f;
#pragma unroll
    for (int e = 0; e < 4; ++e) { run += logsig(SMALL[(size_t)(b * SEQ + tid * 4 + e) * 32 + 16 + h] + bf_); p[e] = run; }
    float sc = run;
#pragma unroll
    for (int o = 1; o < 64; o <<= 1) { const float t = __builtin_bit_cast(float, __builtin_amdgcn_ds_bpermute(((lane - o) & 63) << 2, __builtin_bit_cast(int, sc))); if (lane >= o) sc += t; }
    __syncthreads();
    if (lane == 63) WTOT[wave] = sc;
    __syncthreads();
    float off = sc - run;
    for (int w = 0; w < wave; ++w) off += WTOT[w];
    const float NL = -1.4426950408889634f;
    *(f32x4*)((float*)(ws + WS_CUMG) + (size_t)item * SEQ + tid * 4) = (f32x4){(off + p[0]) * NL, (off + p[1]) * NL, (off + p[2]) * NL, (off + p[3]) * NL};
}
__device__ __forceinline__ void gla_item(const Args& a, LAS unsigned char* lds, int item, int tid_in, int wave, int lane_in) {
    unsigned char* ws = a.ws;
    int tid = tid_in; asm volatile("" : "+v"(tid)); const int lane = tid & 63; (void)lane_in;
    const int bh = item >> 3, slice = item & 7, b = bh >> 2, h = bh & 3;
    LAS unsigned char* QD = lds; LAS unsigned char* KI = lds + 33792; LAS unsigned char* KDT = lds + 67584; LAS unsigned char* VT = lds + 104448; LAS unsigned char* AT = lds + 113664;
    LAS float* OP = (LAS float*)(lds + 122880); LAS float* EBL = (LAS float*)(lds + 139264); LAS unsigned char* OT = lds + 140288;
    const int fr = lane & 15, quad = lane >> 4;
    const bf16* GQ = (const bf16*)(ws + WS_GQ); const bf16* GK = (const bf16*)(ws + WS_GK); const bf16* GVT = (const bf16*)(ws + WS_GVT);
    const bf16* KDTG = (const bf16*)(ws + WS_KDTG); const float* EBLG = (const float*)(ws + WS_EBLG); bf16* OA = (bf16*)(ws + WS_OA);
    const int hf = wave >> 2, dvt = wave & 3;
    f32x4 st[8];
#pragma unroll
    for (int r = 0; r < 8; ++r) st[r] = (f32x4){0.f, 0.f, 0.f, 0.f};
    const bf16* gq = GQ + (size_t)(b * SEQ + (tid >> 5)) * 1024 + h * 256 + (tid & 31) * 8;
    const bf16* gk = GK + (size_t)(b * SEQ + (tid >> 5)) * 1024 + h * 256 + (tid & 31) * 8;
    const bf16* gd = KDTG + ((size_t)(bh * 32) * 256 + (tid >> 3)) * 64 + (tid & 7) * 8;
    const bf16* gv = GVT + ((size_t)(b * 32) * DM + h * 512 + slice * 64 + (tid >> 3)) * 64 + (tid & 7) * 8;
    const float* ge = EBLG + (size_t)(bh * 32) * 256 + (tid & 255);
    struct PF { u32x4 q[4], k[4], d[4], v; float e; };
    PF pfA;
#define GLA_LOAD(P_, c_) do { _Pragma("unroll") for (int i = 0; i < 4; ++i) { P_.q[i] = *(const u32x4*)(gq + (size_t)((c_) * 64 + i * 16) * 1024); P_.k[i] = *(const u32x4*)(gk + (size_t)((c_) * 64 + i * 16) * 1024); \
        P_.d[i] = *(const u32x4*)(gd + (size_t)(c_) * 256 * 64 + (size_t)i * 64 * 64); } P_.v = *(const u32x4*)(gv + (size_t)(c_) * DM * 64); P_.e = ge[(size_t)(c_) * 256]; } while (0)
#define GLA_STORE(P_) do { _Pragma("unroll") for (int i = 0; i < 4; ++i) { *(LAS u32x4*)(QD + ((tid >> 5) + i * 16) * 528 + (tid & 31) * 16) = P_.q[i]; *(LAS u32x4*)(KI + ((tid >> 5) + i * 16) * 528 + (tid & 31) * 16) = P_.k[i]; \
        *(LAS u32x4*)(KDT + ((tid >> 3) + i * 64) * 144 + (tid & 7) * 16) = P_.d[i]; } *(LAS u32x4*)(VT + (tid >> 3) * 144 + (tid & 7) * 16) = P_.v; if (tid < 256) EBL[tid] = P_.e; } while (0)
    GLA_LOAD(pfA, 0);
    const LAS unsigned char* QDl = QD + fr * 528 + quad * 16; const LAS unsigned char* KIl = KI + fr * 528 + quad * 16;
    const LAS unsigned char* KDl = KDT + (hf * 128 + fr) * 144 + quad * 16; const LAS unsigned char* VTl = VT + (dvt * 16 + fr) * 144 + quad * 16; const LAS unsigned char* ATl = AT + fr * 144 + hf * 64 + quad * 16;
    for (int c = 0; c < 32; ++c) {
        const int R0 = b * SEQ + c * 64;
        LBAR();
        if (c > 0) { const u32x4 w = *(const LAS u32x4*)(OT + (tid >> 3) * 144 + (tid & 7) * 16);
            *(u32x4*)(OA + (size_t)(R0 - 64 + (tid >> 3)) * DM + h * 512 + slice * 64 + (tid & 7) * 8) = w; }
        GLA_STORE(pfA); if (c + 1 < 32) GLA_LOAD(pfA, c + 1);
        LBAR();
        { const int tq = wave >> 1, sq0 = 2 * (wave & 1);
          f32x4 acc0 = {0.f, 0.f, 0.f, 0.f}, acc1 = {0.f, 0.f, 0.f, 0.f}, acc2 = {0.f, 0.f, 0.f, 0.f}, acc3 = {0.f, 0.f, 0.f, 0.f};
          if (sq0 <= tq) { bf16x8 qa[8], kb[8];
#pragma unroll
              for (int ks = 0; ks < 8; ++ks) { qa[ks] = *(const LAS bf16x8*)(QDl + tq * 16 * 528 + ks * 64); kb[ks] = *(const LAS bf16x8*)(KIl + sq0 * 16 * 528 + ks * 64); }
              __builtin_amdgcn_sched_barrier(0);
#pragma unroll
              for (int ks = 0; ks < 8; ks += 2) { acc0 = MFMA16(qa[ks], kb[ks], acc0); acc1 = MFMA16(qa[ks + 1], kb[ks + 1], acc1); }
              __builtin_amdgcn_sched_barrier(0);
              if (sq0 + 1 <= tq) {
#pragma unroll
                  for (int ks = 0; ks < 8; ++ks) kb[ks] = *(const LAS bf16x8*)(KIl + (sq0 + 1) * 16 * 528 + ks * 64);
                  __builtin_amdgcn_sched_barrier(0);
#pragma unroll
                  for (int ks = 0; ks < 8; ks += 2) { acc2 = MFMA16(qa[ks], kb[ks], acc2); acc3 = MFMA16(qa[ks + 1], kb[ks + 1], acc3); }
                  __builtin_amdgcn_sched_barrier(0); } }
          acc0 = acc0 + acc1; acc2 = acc2 + acc3;
#pragma unroll
          for (int i = 0; i < 4; ++i) { const int t = tq * 16 + quad * 4 + i, s = sq0 * 16 + fr;
              *(LAS bf16*)(AT + t * 144 + s * 2) = (bf16)f2bf((s <= t) ? acc0[i] : 0.f);
              *(LAS bf16*)(AT + t * 144 + (s + 16) * 2) = (bf16)f2bf((s + 16 <= t) ? acc2[i] : 0.f); } }
        LBAR();
        f32x4 o[4];
        { bf16x8 aa[4], qa[2][4]; const bf16x8 vb = *(const LAS bf16x8*)(VTl + hf * 64);
#pragma unroll
          for (int tq = 0; tq < 4; ++tq) { aa[tq] = *(const LAS bf16x8*)(ATl + tq * 16 * 144); qa[0][tq] = *(const LAS bf16x8*)(QDl + tq * 16 * 528 + hf * 256); }
          __builtin_amdgcn_sched_barrier(0);
#pragma unroll
          for (int tq = 0; tq < 4; ++tq) o[tq] = MFMA16(aa[tq], vb, ((f32x4){0.f, 0.f, 0.f, 0.f}));
#pragma unroll
          for (int kk = 0; kk < 4; ++kk) { u32x4 bw; bw.x = pk2(st[2 * kk][0], st[2 * kk][1]); bw.y = pk2(st[2 * kk][2], st[2 * kk][3]); bw.z = pk2(st[2 * kk + 1][0], st[2 * kk + 1][1]); bw.w = pk2(st[2 * kk + 1][2], st[2 * kk + 1][3]);
              const bf16x8 bv = __builtin_bit_cast(bf16x8, bw);
              if (kk < 3) {
#pragma unroll
                  for (int tq = 0; tq < 4; ++tq) qa[(kk + 1) & 1][tq] = *(const LAS bf16x8*)(QDl + tq * 16 * 528 + hf * 256 + (kk + 1) * 64); }
              __builtin_amdgcn_sched_barrier(0);
#pragma unroll
              for (int tq = 0; tq < 4; ++tq) o[tq] = MFMA16(qa[kk & 1][tq], bv, o[tq]);
              __builtin_amdgcn_sched_barrier(0); } }
        if (hf == 1) {
#pragma unroll
            for (int tq = 0; tq < 4; ++tq)
#pragma unroll
                for (int i = 0; i < 4; ++i) OP[(tq * 16 + quad * 4 + i) * 64 + dvt * 16 + fr] = o[tq][i]; }
        { bf16x8 ka[2][4]; const bf16x8 v0 = *(const LAS bf16x8*)VTl, v1 = *(const LAS bf16x8*)(VTl + 64); f32x4 e4[8];
#pragma unroll
          for (int rt = 0; rt < 8; ++rt) e4[rt] = *(const LAS f32x4*)(EBL + hf * 128 + rt * 16 + quad * 4);
#pragma unroll
          for (int r2 = 0; r2 < 2; ++r2) { ka[0][2 * r2] = *(const LAS bf16x8*)(KDl + r2 * 16 * 144); ka[0][2 * r2 + 1] = *(const LAS bf16x8*)(KDl + r2 * 16 * 144 + 64); }
          __builtin_amdgcn_sched_barrier(0);
#pragma unroll
          for (int rp = 0; rp < 4; ++rp) {
              if (rp < 3) {
#pragma unroll
                  for (int r2 = 0; r2 < 2; ++r2) { ka[(rp + 1) & 1][2 * r2] = *(const LAS bf16x8*)(KDl + (2 * rp + 2 + r2) * 16 * 144); ka[(rp + 1) & 1][2 * r2 + 1] = *(const LAS bf16x8*)(KDl + (2 * rp + 2 + r2) * 16 * 144 + 64); } }
              st[2 * rp] = st[2 * rp] * e4[2 * rp]; st[2 * rp + 1] = st[2 * rp + 1] * e4[2 * rp + 1];
              __builtin_amdgcn_sched_barrier(0);
              st[2 * rp] = MFMA16(ka[rp & 1][0], v0, st[2 * rp]); st[2 * rp + 1] = MFMA16(ka[rp & 1][2], v0, st[2 * rp + 1]);
              st[2 * rp] = MFMA16(ka[rp & 1][1], v1, st[2 * rp]); st[2 * rp + 1] = MFMA16(ka[rp & 1][3], v1, st[2 * rp + 1]);
              __builtin_amdgcn_sched_barrier(0); } }
        LBAR();
        if (hf == 0) { float opv[16];
#pragma unroll
            for (int tq = 0; tq < 4; ++tq)
#pragma unroll
                for (int i = 0; i < 4; ++i) opv[tq * 4 + i] = OP[(tq * 16 + quad * 4 + i) * 64 + dvt * 16 + fr];
            __builtin_amdgcn_sched_barrier(0);
#pragma unroll
            for (int tq = 0; tq < 4; ++tq)
#pragma unroll
                for (int i = 0; i < 4; ++i) *(LAS bf16*)(OT + (tq * 16 + quad * 4 + i) * 144 + (dvt * 16 + fr) * 2) = (bf16)f2bf(o[tq][i] + opv[tq * 4 + i]); }
    }
    LBAR();
    { const u32x4 w = *(const LAS u32x4*)(OT + (tid >> 3) * 144 + (tid & 7) * 16);
      *(u32x4*)(OA + (size_t)(b * SEQ + 31 * 64 + (tid >> 3)) * DM + h * 512 + slice * 64 + (tid & 7) * 8) = w; }
#undef GLA_LOAD
#undef GLA_STORE
    __syncthreads();
}

#define FOX_DMA(jj_, st_) do { _Pragma("unroll") for (int i_ = 0; i_ < 2; ++i_) { \
        __builtin_amdgcn_global_load_lds((const unsigned*)(kgp[i_] + (size_t)(jj_) * 64 * DM), (LAS unsigned*)(lds + (st_) * 32768 + (wave * 2 + i_) * 1024), 16, 0, 0); \
        __builtin_amdgcn_global_load_lds((const unsigned*)(vgp[i_] + (size_t)(jj_) * DM * 64), (LAS unsigned*)(lds + (st_) * 32768 + 16384 + (wave * 2 + i_) * 1024), 16, 0, 0); } } while (0)
template <int ST>
__device__ __forceinline__ void fox_tile(LAS unsigned char* lds, const LAS float* CUM, int wave, int lane, int fr, int quad, int j, int ntile, int q0,
                                         const bf16* const (&kgp)[2], const bf16* const (&vgp)[2], const unsigned (&kro)[4], const unsigned (&vro)[2],
                                         const bf16x8 (&qf)[2][4], f32x4 (&o)[2][8], float (&mrun)[2], float (&lrun)[2]) {
    const float SCL = 0.08838834764831845f * 1.4426950408889634f;
    if (j + 1 < ntile) FOX_DMA(j + 1, ST ^ 1);
    if (j * 64 <= q0 + 31) {
    const LAS unsigned char* KTs = lds + ST * 32768; const LAS unsigned char* VTs = lds + ST * 32768 + 16384;
    f32x4 s[2][4]; bf16x8 kf[4];
#define KFRAG(i_) (*(const LAS bf16x8*)(KTs + ((i_) >> 2) * 4096 + kro[(i_) & 3]))
    kf[0] = KFRAG(0); kf[1] = KFRAG(1); kf[2] = KFRAG(2);
#pragma unroll
    for (int mt = 0; mt < 4; ++mt) { s[0][mt] = (f32x4){0.f, 0.f, 0.f, 0.f}; s[1][mt] = (f32x4){0.f, 0.f, 0.f, 0.f}; }
#pragma unroll
    for (int i = 0; i < 16; ++i) {
        if (i + 3 < 16) kf[(i + 3) & 3] = KFRAG(i + 3);
        __builtin_amdgcn_sched_barrier(0);
        s[0][i >> 2] = MFMA16(kf[i & 3], qf[0][i & 3], s[0][i >> 2]); s[1][i >> 2] = MFMA16(kf[i & 3], qf[1][i & 3], s[1][i >> 2]);
        __builtin_amdgcn_sched_barrier(0); }
#undef KFRAG
    bf16x8 vf[3];
#define VFRAG(i_) (*(const LAS bf16x8*)(VTs + ((i_) >> 1) * 2048 + vro[(i_) & 1]))
    vf[0] = VFRAG(0); vf[1] = VFRAG(1);
    const bool diag = (j * 64 + 63 > q0);
    bf16x8 pb[2][2];
#pragma unroll
    for (int sub = 0; sub < 2; ++sub) { const int q = q0 + sub * 16 + fr; float mx = -__builtin_inff();
#pragma unroll
        for (int mt = 0; mt < 4; ++mt) { const f32x4 ck = *(const LAS f32x4*)(CUM + j * 64 + mt * 16 + quad * 4);
#pragma unroll
            for (int i = 0; i < 4; ++i) { float v = fmaf(s[sub][mt][i], SCL, ck[i]);
                if (diag && (j * 64 + mt * 16 + quad * 4 + i > q)) v = -__builtin_inff();
                s[sub][mt][i] = v; mx = fmaxf(mx, v); } }
        mx = fmaxf(mx, shx(mx, 16, lane)); mx = fmaxf(mx, shx(mx, 32, lane));
        if (!__all(mx - mrun[sub] <= 8.f)) {
            const float mn = fmaxf(mrun[sub], mx), alpha = __builtin_amdgcn_exp2f(mrun[sub] - mn); mrun[sub] = mn; lrun[sub] *= alpha;
#pragma unroll
            for (int d = 0; d < 8; ++d) o[sub][d] = o[sub][d] * alpha; }
        const float mn = mrun[sub]; float ps = 0.f;
#pragma unroll
        for (int mt = 0; mt < 4; ++mt)
#pragma unroll
            for (int i = 0; i < 4; ++i) { const float p = __builtin_amdgcn_exp2f(s[sub][mt][i] - mn); s[sub][mt][i] = p; ps += p; }
        lrun[sub] += ps;
#pragma unroll
        for (int k2 = 0; k2 < 2; ++k2) { u32x4 w; w.x = pk2(s[sub][2 * k2][0], s[sub][2 * k2][1]); w.y = pk2(s[sub][2 * k2][2], s[sub][2 * k2][3]);
            w.z = pk2(s[sub][2 * k2 + 1][0], s[sub][2 * k2 + 1][1]); w.w = pk2(s[sub][2 * k2 + 1][2], s[sub][2 * k2 + 1][3]); pb[sub][k2] = __builtin_bit_cast(bf16x8, w); } }
    __builtin_amdgcn_sched_barrier(0);
#pragma unroll
    for (int i = 0; i < 16; ++i) {
        if (i + 2 < 16) vf[(i + 2) % 3] = VFRAG(i + 2);
        __builtin_amdgcn_sched_barrier(0);
        o[0][i >> 1] = MFMA16(vf[i % 3], pb[0][i & 1], o[0][i >> 1]); o[1][i >> 1] = MFMA16(vf[i % 3], pb[1][i & 1], o[1][i >> 1]);
        __builtin_amdgcn_sched_barrier(0); }
#undef VFRAG
    }
    asm volatile("s_waitcnt vmcnt(0)" ::: "memory");
    LBAR();
}
__device__ __forceinline__ void fox_item(const Args& a, LAS unsigned char* lds, int item, int tid_in, int wave, int lane_in) {
    unsigned char* ws = a.ws;
    int tid = tid_in; asm volatile("" : "+v"(tid)); (void)lane_in;
    const int bh = item >> 2, x = item & 3, b = bh >> 4, h = bh & 15;
    LAS float* CUM = (LAS float*)(lds + 65536);
    const bf16* FQ = (const bf16*)(ws + WS_FQ); const bf16* FK = (const bf16*)(ws + WS_FK); const bf16* FVT = (const bf16*)(ws + WS_FVT);
    bf16* OB = (bf16*)((unsigned char*)a.out + 64 * MiB);
    __syncthreads();
    *(LAS f32x4*)(CUM + tid * 4) = *(const f32x4*)((const float*)(ws + WS_CUMG) + (size_t)bh * SEQ + tid * 4);
    __syncthreads();
    for (int pass = 0; pass < 2; ++pass) {
        const int lane = my_lane(), fr = lane & 15, quad = lane >> 4;
        const int qb = pass ? 7 - x : x, ntile = (qb + 1) * 4, q0 = qb * 256 + wave * 32;
        bf16x8 qf[2][4]; float mrun[2], lrun[2]; f32x4 o[2][8];
#pragma unroll
        for (int sub = 0; sub < 2; ++sub) { const int q = q0 + sub * 16 + fr; mrun[sub] = -1e30f; lrun[sub] = 0.f;
#pragma unroll
            for (int ks = 0; ks < 4; ++ks) qf[sub][ks] = *(const bf16x8*)(FQ + (size_t)(b * SEQ + q) * DM + h * 128 + ks * 32 + quad * 8);
#pragma unroll
            for (int d = 0; d < 8; ++d) o[sub][d] = (f32x4){0.f, 0.f, 0.f, 0.f}; }
        const bf16* kgp[2]; const bf16* vgp[2];
#pragma unroll
        for (int i = 0; i < 2; ++i) { const int L = (wave * 2 + i) * 64 + lane;
            { const int row = L >> 4, c = (L & 15) ^ (row & 15); kgp[i] = FK + (size_t)(b * SEQ + row) * DM + h * 128 + c * 8; }
            { const int row = L >> 3, c = (L & 7) ^ ((row >> 1) & 7); vgp[i] = FVT + ((size_t)(b * 32) * DM + h * 128 + row) * 64 + c * 8; } }
        unsigned kro[4], vro[2];
#pragma unroll
        for (int ks = 0; ks < 4; ++ks) kro[ks] = (unsigned)(fr * 256 + (((ks * 4 + quad) ^ fr) << 4));
#pragma unroll
        for (int k2 = 0; k2 < 2; ++k2) vro[k2] = (unsigned)(fr * 128 + (((k2 * 4 + quad) ^ ((fr >> 1) & 7)) << 4));
        FOX_DMA(0, 0);
        asm volatile("s_waitcnt vmcnt(0)" ::: "memory");
        LBAR();
        for (int j = 0; j < ntile; j += 2) {
            fox_tile<0>(lds, CUM, wave, lane, fr, quad, j, ntile, q0, kgp, vgp, kro, vro, qf, o, mrun, lrun);
            fox_tile<1>(lds, CUM, wave, lane, fr, quad, j + 1, ntile, q0, kgp, vgp, kro, vro, qf, o, mrun, lrun);
        }
#pragma unroll
        for (int sub = 0; sub < 2; ++sub) { float lt = lrun[sub]; lt += shx(lt, 16, lane); lt += shx(lt, 32, lane); const float inv = 1.f / lt; bf16* op = OB + (size_t)(b * SEQ + q0 + sub * 16 + fr) * DM + h * 128 + quad * 4;
#pragma unroll
            for (int d = 0; d < 8; ++d) { u32x2 w; w.x = pk2(o[sub][d][0] * inv, o[sub][d][1] * inv); w.y = pk2(o[sub][d][2] * inv, o[sub][d][3] * inv); *(u32x2*)(op + d * 16) = w; } }
    }
    __syncthreads();
}
#undef FOX_DMA

__device__ __forceinline__ void fix_row(const Args& a, int row, int lane) {
    unsigned char* ws = a.ws; bf16* OA = (bf16*)(ws + WS_OA) + (size_t)row * DM; const bf16* GG = (const bf16*)(ws + WS_GG) + (size_t)row * DM;
    const f32x4 g0 = *(const f32x4*)(a.in[8] + lane * 8), g1 = *(const f32x4*)(a.in[8] + lane * 8 + 4);
#pragma unroll
    for (int hh = 0; hh < 4; ++hh) { const u32x4 w = *(const u32x4*)(OA + hh * 512 + lane * 8); const u32x4 gw = *(const u32x4*)(GG + hh * 512 + lane * 8);
        float v[8] = {bflo(w.x), bfhi(w.x), bflo(w.y), bfhi(w.y), bflo(w.z), bfhi(w.z), bflo(w.w), bfhi(w.w)};
        float gv[8] = {bflo(gw.x), bfhi(gw.x), bflo(gw.y), bfhi(gw.y), bflo(gw.z), bfhi(gw.z), bflo(gw.w), bfhi(gw.w)};
        float ss = 0.f;
#pragma unroll
        for (int e = 0; e < 8; ++e) ss += v[e] * v[e];
        const float rstd = rsqrtf(wave_sum(ss, lane) * (1.f / 512.f) + EPS);
        float r[8];
#pragma unroll
        for (int e = 0; e < 8; ++e) { const float gl = e < 4 ? g0[e] : g1[e - 4]; r[e] = v[e] * rstd * gl * (gv[e] * sigmoidf_(gv[e])); }
        u32x4 ow; ow.x = pk2(r[0], r[1]); ow.y = pk2(r[2], r[3]); ow.z = pk2(r[4], r[5]); ow.w = pk2(r[6], r[7]);
        *(u32x4*)(OA + hh * 512 + lane * 8) = ow; }
}
__device__ __forceinline__ void final_finish(const RowRegs& R, float* orow, const float* g, int lane) {
    float ss = 0.f;
#pragma unroll
    for (int j = 0; j < 8; ++j) ss += (R.v[j][0] * R.v[j][0] + R.v[j][1] * R.v[j][1]) + (R.v[j][2] * R.v[j][2] + R.v[j][3] * R.v[j][3]);
    const float rstd = rsqrtf(wave_sum(ss, lane) * (1.f / DM) + EPS);
#pragma unroll
    for (int j = 0; j < 8; ++j) { const int col = row_col<true>(j, lane); const f32x4 gg = *(const f32x4*)(g + col); *(f32x4*)(orow + col) = R.v[j] * rstd * gg; }
}

#define XB_TMO      128
#define XB_XCNT(j)  (256  + 64 * (j))
#define XB_XSUB(j)  (1280 + 64 * (j))
#define XB_XGEN(j)  (2304 + 64 * (j))
#define XB_TOP      3328
#define XB_TOPGEN   3392
#define XCD_BAR_WORDS 3456
#define XB_SPIN_CAP (1u << 18)

__device__ __forceinline__ unsigned xb_ld(unsigned* p)              { return __hip_atomic_load(p, __ATOMIC_RELAXED, __HIP_MEMORY_SCOPE_AGENT); }
__device__ __forceinline__ unsigned xb_add(unsigned* p, unsigned v) { return __hip_atomic_fetch_add(p, v, __ATOMIC_RELAXED, __HIP_MEMORY_SCOPE_AGENT); }
__device__ __forceinline__ unsigned xb_xcc_id() { return (unsigned)__builtin_amdgcn_s_getreg((3 << 11) | 20) & 0xFu; }
#define XB_SPIN(cond, bar) do { unsigned _sp = 0; while (cond) { __builtin_amdgcn_s_sleep(1); \
    if ((++_sp & 255u) == 0u) { if (xb_ld(&(bar)[XB_TMO])) break; if (_sp > XB_SPIN_CAP) { atomicAdd(&(bar)[XB_TMO], 1u); break; } } } } while (0)

struct XcdBarrier {
    unsigned* bar; unsigned x;
    volatile LAS unsigned* st;
};

__device__ __forceinline__ XcdBarrier xcd_barrier_post(unsigned* bar, volatile LAS unsigned* st, int tid_) {
    XcdBarrier b; b.bar = bar; b.x = xb_xcc_id(); b.st = st;
    if (tid_ == 0) st[2] = xb_add(&bar[XB_XCNT(b.x)], 1u);
    return b;
}
__device__ __forceinline__ void xcd_barrier_complete(unsigned* bar, unsigned x, unsigned& nloc, unsigned& nx) {
    const unsigned G = gridDim.x * gridDim.y * gridDim.z;
    unsigned sum, cnt, mine, sp = 0u;
    for (;;) {
        sum = 0u; cnt = 0u; mine = 0u;
#pragma unroll
        for (unsigned j = 0; j < 16; ++j) { const unsigned c = xb_ld(&bar[XB_XCNT(j)]); sum += c; cnt += (c > 0u) ? 1u : 0u; mine = (j == x) ? c : mine; }
        if (sum == G) break;
        __builtin_amdgcn_s_sleep(1);
        if ((++sp & 255u) == 0u) { if (xb_ld(&bar[XB_TMO])) break; if (sp > XB_SPIN_CAP) { atomicAdd(&bar[XB_TMO], 1u); break; } }
    }
    nloc = mine > 0u ? mine : 1u; nx = cnt > 0u ? cnt : 1u;
}

__device__ __forceinline__ void xcd_barrier(const XcdBarrier& b, int tid_) {
    asm volatile("s_waitcnt vmcnt(0)" ::: "memory");
    __syncthreads();
    if (tid_ == 0) {
        unsigned* bar = b.bar;
        __builtin_amdgcn_s_waitcnt(0);
        unsigned nloc = b.st[0], nx = b.st[1];
        if (nloc == 0u) { xcd_barrier_complete(bar, b.x, nloc, nx); b.st[0] = nloc; b.st[1] = nx; }
        const unsigned old = xb_add(&bar[XB_XSUB(b.x)], 1u);
        const unsigned gen = old / nloc;
        if (old + 1u == (gen + 1u) * nloc) {
            __builtin_amdgcn_fence(__ATOMIC_RELEASE, "agent");
            asm volatile("s_waitcnt vmcnt(0)" ::: "memory");
            const unsigned og = xb_add(&bar[XB_TOP], 1u);
            const unsigned tg = og / nx;
            if (og + 1u == (tg + 1u) * nx) xb_add(&bar[XB_TOPGEN], 1u);
            else XB_SPIN(xb_ld(&bar[XB_TOPGEN]) == tg, bar);
            __builtin_amdgcn_fence(__ATOMIC_ACQUIRE, "agent");
            xb_add(&bar[XB_XGEN(b.x)], 1u);
            asm volatile("s_waitcnt vmcnt(0)" ::: "memory");
        } else {
            XB_SPIN(xb_ld(&bar[XB_XGEN(b.x)]) == gen, bar);
            __builtin_amdgcn_fence(__ATOMIC_ACQUIRE, "agent");
            asm volatile("s_waitcnt vmcnt(0)" ::: "memory");
        }
    }
    __syncthreads();
}

#define WGM_G1A 4
#define WGM_G1B 4
#define WGM_DUAL 4
#define WGM_G3 4
#define WGM_G4 4
#define WGM_G5 4
#define REP_P0 1
#define REP_G1A 1
#define REP_GLA 1
#define REP_FOX 1
#define REP_G4 1
#define REP_G3 1
#define REP_P1 1
#define REP_P7 1
#define REP_G1B 1
#define REP_G2A 1
#define REP_G2B 1
__global__ void __launch_bounds__(512, 2) hybrid_fwd(Args a) {
    extern __shared__ __attribute__((aligned(16))) unsigned char lds_raw[];
    LAS unsigned char* lds = (LAS unsigned char*)lds_raw;
    cg::grid_group grid = cg::this_grid();
    const int G = gridDim.x, NGW = G * 8;
    const int wave0 = __builtin_amdgcn_readfirstlane((int)(threadIdx.x >> 6));
#define MYTID() (wave0 * 64 + my_lane())
    unsigned* barw = (unsigned*)(a.ws + WS_CTL);
    volatile LAS unsigned* MISC = (volatile LAS unsigned*)(lds + LDS_BYTES - 64);
    { const int t0 = MYTID(); if (t0 < 16) MISC[t0] = 0u;
      if (blockIdx.x == 0) for (int i = t0; i < XCD_BAR_WORDS; i += 512) barw[i] = 0u; }
    __syncthreads();
#define FRESH() int tid = MYTID(); asm volatile("" : "+v"(tid)); const int lane = tid & 63, wave = __builtin_amdgcn_readfirstlane(tid >> 6), gw = blockIdx.x * 8 + wave; (void)lane; (void)gw
    unsigned char* ws = a.ws;
    const float* MOD = (const float*)(ws + WS_MOD);

    for (int rep = 0; rep < REP_P0; ++rep) { FRESH(); p0_phase(a, lds, gw, NGW, wave, lane); __syncthreads(); }
    grid.sync();
    const XcdBarrier xbar = xcd_barrier_post(barw, MISC, MYTID());
#define GRID_BAR() do { unsigned long long bp_ = (unsigned long long)(a.ws + WS_CTL); asm volatile("" : "+s"(bp_)); XcdBarrier xb_ = xbar; xb_.bar = (unsigned*)bp_; xcd_barrier(xb_, MYTID()); } while (0)
    for (int rep = 0; rep < REP_P1; ++rep) { FRESH(); p1_phase(a, lds, tid, wave, lane); }
    GRID_BAR();
    for (int rep = 0; rep < REP_G1A; ++rep) {
        pg8::Gemm g{(const bf16*)a.out, (const bf16*)(ws + WS_WINLO), MT, N1A, DM, nullptr, nullptr}; pg8::StaticOrder S; S.init(MT, N1A, G, (int)blockIdx.x, WGM_G1A);
        EpiProj E{ws};
        pg8::gemm_phase<EpiProj, pg8::StaticOrder, true, true>(lds, g, S, E, MYTID());
    }
    GRID_BAR();
    { FRESH(); for (int it = blockIdx.x; it < 1024; it += G) gla_prep_unit(a, lds, it, tid);
      __syncthreads();
      for (int it = blockIdx.x; it < 128; it += G) cum_item(a, lds, it, tid, wave, lane); }
    GRID_BAR();
    int vb = (int)blockIdx.x;
    if (G == 256) { bool even = true;
        for (unsigned j = 0; j < 8; ++j) even = even && (xb_ld(&barw[XB_XCNT(j)]) == 32u);
        const unsigned xr = MISC[2];
        vb = (even && xbar.x < 8u && xr < 32u) ? (int)(xbar.x * 32u + xr) : (int)((blockIdx.x & 7) * 32 + (blockIdx.x >> 3)); }
    vb = __builtin_amdgcn_readfirstlane(vb);
    for (int rep = 0; rep < REP_GLA; ++rep)
    for (int it = vb; it < 256; it += G) { FRESH(); gla_item(a, lds, it, tid, wave, lane); }
    for (int rep = 0; rep < REP_FOX; ++rep)
    for (int it = vb; it < 512; it += G) { FRESH(); fox_item(a, lds, it, tid, wave, lane); }
    GRID_BAR();
    {
        FRESH();
        for (int row = gw; row < MT; row += NGW) fix_row(a, row, lane);
        LAS float* scr = (LAS float*)(lds + wave * 16896);
        for (int it = gw; it < 32 * 128; it += NGW) tr_plain(a.in[14], DM, DFF, (bf16*)(ws + WS_W1), it, scr, lane);
        for (int it = gw; it < 128 * 32; it += NGW) tr_plain(a.in[15], DFF, DM, (bf16*)(ws + WS_W2), it, scr, lane);
        { unsigned* z = (unsigned*)(ws + WS_ROWSS); for (int i = gw * 64 + lane; i < (229376 - 65536) / 4; i += NGW * 64) z[i] = 0u; }
        __syncthreads();
        pg8::Gemm g{(const bf16*)a.out, (const bf16*)(ws + WS_WINHI), MT, N1B, DM, nullptr, nullptr}; pg8::StaticOrder S; S.init(MT, N1B, G, (int)blockIdx.x, WGM_G1B);
        EpiGen<0> E{(bf16*)(ws + WS_SGA), 2048, nullptr, nullptr, nullptr, nullptr, nullptr};
        for (int rep = 0; rep < REP_G1B; ++rep) pg8::gemm_phase<EpiGen<0>, pg8::StaticOrder, true, true>(lds, g, S, E, MYTID());
    }
    GRID_BAR();
    {
        pg8::DualOrder S; S.init(MT, DM, G, (int)blockIdx.x, WGM_DUAL);
        pg8::Gemm g{(const bf16*)(ws + WS_OA), (const bf16*)(ws + WS_WA), MT, DM, DM, (const bf16*)((unsigned char*)a.out + 64 * MiB), (const bf16*)(ws + WS_WB)};
        EpiDual E{(bf16*)(ws + WS_MG), (const bf16*)(ws + WS_SGA), (const bf16*)(ws + WS_SGB)};
        pg8::gemm_phase<EpiDual, pg8::DualOrder, true, true>(lds, g, S, E, MYTID());
    }
    GRID_BAR();
    for (int rep = 0; rep < REP_G3; ++rep) {
        pg8::Gemm g{(const bf16*)(ws + WS_MG), (const bf16*)(ws + WS_WO), MT, DM, DM, nullptr, nullptr}; pg8::StaticOrder S; S.init(MT, DM, G, (int)blockIdx.x, WGM_G3);
        if (G == 256) {
            EpiMid E{(bf16*)(ws + WS_X1B), (bf16*)(ws + WS_H2), a.in[0], MOD, a.in[13], (float*)(ws + WS_ROWSS2), (unsigned*)(ws + WS_PCNT2), (LAS float*)(lds + 131072)};
            pg8::gemm_phase<EpiMid, pg8::StaticOrder, true, true>(lds, g, S, E, MYTID());
        } else {
            EpiGen<5> E{(bf16*)(ws + WS_X1B), 2048, nullptr, nullptr, a.in[0], nullptr, MOD + 2 * DM};
            pg8::gemm_phase<EpiGen<5>, pg8::StaticOrder, true, true>(lds, g, S, E, MYTID());
        }
    }
    GRID_BAR();
    if (G != 256) {
        FRESH();
        bf16* H2 = (bf16*)(ws + WS_H2);
        for (int row = 2 * gw; row < MT; row += 2 * NGW) { const float* mb = MOD + (size_t)(row / SEQ) * NMOD; RowRegs R0, R1;
            row_load_b16(R0, (const bf16*)(ws + WS_X1B) + (size_t)row * DM, lane); row_load_b16(R1, (const bf16*)(ws + WS_X1B) + (size_t)(row + 1) * DM, lane);
            norm_finish_bf16<const float*, true>(R0, a.in[13], mb + 4 * DM, mb + 3 * DM, H2 + (size_t)row * DM, lane);
            norm_finish_bf16<const float*, true>(R1, a.in[13], mb + 4 * DM, mb + 3 * DM, H2 + (size_t)(row + 1) * DM, lane); }
        __syncthreads();
        GRID_BAR();
    }
    for (int rep = 0; rep < REP_G4; ++rep) {
        pg8::Gemm g{(const bf16*)(ws + WS_H2), (const bf16*)(ws + WS_W1), MT, DFF, DM, nullptr, nullptr}; pg8::StaticOrder S; S.init(MT, DFF, G, (int)blockIdx.x, WGM_G4);
        EpiGen<4> E{(bf16*)(ws + WS_U), DFF, nullptr, nullptr, nullptr, nullptr, nullptr};
        pg8::gemm_phase<EpiGen<4>, pg8::StaticOrder, true, true>(lds, g, S, E, MYTID());
    }
    GRID_BAR();
    {
        pg8::Gemm g{(const bf16*)(ws + WS_U), (const bf16*)(ws + WS_W2), MT, DM, DFF, nullptr, nullptr}; pg8::StaticOrder S; S.init(MT, DM, G, (int)blockIdx.x, WGM_G5);
        if (G == 256) {
            EpiFinal E{a.out, (const bf16*)(ws + WS_X1B), MOD + 5 * DM, a.in[16], (float*)(ws + WS_ROWSS), (unsigned*)(ws + WS_PCNT), (LAS float*)(lds + 131072)};
            pg8::gemm_phase<EpiFinal, pg8::StaticOrder, true, true>(lds, g, S, E, MYTID());
        } else {
            EpiGen<6> E{(bf16*)(ws + WS_X2B), 2048, (const bf16*)(ws + WS_X1B), nullptr, nullptr, nullptr, MOD + 5 * DM};
            pg8::gemm_phase<EpiGen<6>, pg8::StaticOrder, true, true>(lds, g, S, E, MYTID());
        }
    }
    if (G != 256) {
        GRID_BAR();
        { FRESH(); for (int row = 2 * gw; row < MT; row += 2 * NGW) { RowRegs R0, R1; const bf16* X2B = (const bf16*)(ws + WS_X2B); row_load_b16(R0, X2B + (size_t)row * DM, lane); row_load_b16(R1, X2B + (size_t)(row + 1) * DM, lane);
            final_finish(R0, a.out + (size_t)row * DM, a.in[16], lane); final_finish(R1, a.out + (size_t)(row + 1) * DM, a.in[16], lane); } }
    }
}

extern "C" void kernel_launch(void* const* d_in, const int* in_sizes, int n_in, void* d_out, int out_size, void* d_ws, size_t ws_size, hipStream_t stream) {
    static int grid = 0;
    if (grid == 0) {
        if (n_in != 17 || out_size != MT * DM || ws_size < WS_END) { fprintf(stderr, "kernel_launch: unexpected shapes (n_in %d out %d ws %zu)\n", n_in, out_size, ws_size); grid = -1; return; }
        int dev = 0, cus = 0, per_cu = 0;
        (void)hipGetDevice(&dev); (void)hipDeviceGetAttribute(&cus, hipDeviceAttributeMultiprocessorCount, dev);
        (void)hipFuncSetAttribute((const void*)hybrid_fwd, hipFuncAttributeMaxDynamicSharedMemorySize, LDS_BYTES);
        (void)hipOccupancyMaxActiveBlocksPerMultiprocessor(&per_cu, (const void*)hybrid_fwd, 512, LDS_BYTES);
        if (per_cu < 1) { fprintf(stderr, "kernel_launch: occupancy query says %d blocks per CU\n", per_cu); per_cu = 1; }
        (void)hipGetLastError();
        grid = cus > 0 ? cus : 256;
    }
    if (grid < 0) return;
    Args a{};
    for (int i = 0; i < 17; ++i) a.in[i] = (const float*)d_in[i];
    a.out = (float*)d_out; a.ws = (unsigned char*)d_ws;
    void* args[] = {&a};
    hipError_t e = hipLaunchCooperativeKernel((const void*)hybrid_fwd, dim3(grid), dim3(512), args, LDS_BYTES, stream);
    if (e != hipSuccess) fprintf(stderr, "cooperative launch failed: %s (grid %d)\n", hipGetErrorString(e), grid);
}
```

```cpp
#include <hip/hip_runtime.h>
#include <hip/hip_cooperative_groups.h>
#include <cstdio>
#include <cstdint>
namespace cg = cooperative_groups;
namespace pg8 {
#define PG8_LAS __attribute__((address_space(3)))
typedef unsigned short bf16_t;
typedef short bf16x8 __attribute__((ext_vector_type(8)));
typedef float f32x4 __attribute__((ext_vector_type(4)));
typedef unsigned u32x4 __attribute__((ext_vector_type(4)));
constexpr int BM = 256, BK = 64, HALF = 128, HTB = HALF * BK * 2  , STAGE_BYTES = 8 * HTB, NXCD = 8, WGM = 4;

__host__ __device__ __forceinline__ int lds_byte(int r, int c) { const int st = (r >> 4) * 2 + (c >> 5), rr = r & 15, cc = c & 31, ob = rr * 64 + cc * 2; return st * 1024 + (ob ^ (((ob >> 9) & 1) << 5)); }
__host__ __device__ __forceinline__ void stage_rc(int b, int& R, int& C) { const int st = b / 1024, sb = b % 1024, swz = sb ^ (((sb >> 9) & 1) << 5); R = (st >> 1) * 16 + swz / 64; C = (st & 1) * 32 + (swz % 64) / 2; }
__host__ __device__ __forceinline__ int perm32(int rho) { const int n = rho >> 4, i = rho & 15; return 8 * (i >> 2) + 4 * n + (i & 3); }

struct Unit { int pm, pn, z; };
struct Gemm { const bf16_t* A; const bf16_t* Bt; int M, N, K; const bf16_t* A2; const bf16_t* Bt2; };

struct StaticOrder {
    int nM, nN, nwg, G, c, wgm;
    __host__ __device__ void init(int M, int N, int G_, int c_, int wgm_ = WGM) { nM = M / BM; nN = N / BM; nwg = nM * nN; G = G_; c = c_; wgm = wgm_; }
    __host__ __device__ bool next(int i, Unit& u) const {
        const long L = (long)i * G + c; if (L >= nwg) return false;
        int wgid = (int)L; { const int q = nwg / NXCD, r = nwg % NXCD, xcd = wgid % NXCD, off = wgid / NXCD; wgid = (xcd < r ? xcd * (q + 1) : r * (q + 1) + (xcd - r) * q) + off; }
        const int nig = wgm * nN, gid = wgid / nig, fm = gid * wgm, gsz = (nM - fm) < wgm ? (nM - fm) : wgm;
        u.pm = fm + ((wgid % nig) % gsz); u.pn = (wgid % nig) / gsz; u.z = 0; return true;
    }
    __device__ __forceinline__ void a_ready(const Unit&) const {}
    __device__ __forceinline__ void done(const Unit&) const {}
};
struct DualOrder {
    StaticOrder base;
    __host__ __device__ void init(int M, int N, int G_, int c_, int wgm_ = WGM) { base.init(M, N, G_, c_, wgm_); }
    __host__ __device__ bool next(int i, Unit& u) const { if (!base.next(i >> 1, u)) return false; u.z = i & 1; return true; }
    __device__ __forceinline__ void a_ready(const Unit&) const {}
    __device__ __forceinline__ void done(const Unit&) const {}
};

__device__ __forceinline__ unsigned cvt_pk_bf16(float lo, float hi) { unsigned r; asm volatile("v_cvt_pk_bf16_f32 %0, %1, %2" : "=v"(r) : "v"(lo), "v"(hi)); return r; }
typedef float f32x2 __attribute__((ext_vector_type(2)));
template <class Epi, class Sched, bool ALIGN_EPI = false, bool SP2 = false>
__device__ __forceinline__ void gemm_phase(PG8_LAS unsigned char* lds, const Gemm g, const Sched& S, const Epi& E, int tid_in) {
    int tid_l = tid_in; asm volatile("" : "+v"(tid_l)); const int tid = tid_l, wid = __builtin_amdgcn_readfirstlane(tid >> 6), lane = tid & 63, wr = wid >> 2, wc = wid & 3, fr = lane & 15, fq = lane >> 4;
    const int K = g.K, nt = K / BK;
    unsigned voffA[2], voffB[2];
#pragma unroll
    for (int i = 0; i < 2; ++i) { int R, C; stage_rc(tid * 16 + i * 8192, R, C); const int Rb = Epi::PERM ? ((R & ~31) + perm32(R & 31)) : R;
        voffA[i] = (unsigned)(R * K + C) * 2u; voffB[i] = (unsigned)(Rb * K + C) * 2u; }
    const size_t kstep = (size_t)(BK * 2);
    const size_t hstep = (size_t)HALF * K * 2;
    const size_t tstep = 2 * hstep;
    const unsigned ldsw = (unsigned)wid * 1024u;
    const int aoff = lds_byte(wr * 64 + fr, fq * 8), boff = lds_byte(wc * 32 + fr, fq * 8);
#define PG8_SA(b, h) (((b) * 2 + (h)) * HTB)
#define PG8_SB(b, h) ((4 + (b) * 2 + (h)) * HTB)
#define PG8_STAGE(bufoff, gbase, voff) do { _Pragma("unroll") for (int _i = 0; _i < 2; ++_i) \
        __builtin_amdgcn_global_load_lds((const unsigned*)((const char*)(gbase) + (voff)[_i]), (PG8_LAS unsigned*)(lds + (bufoff) + ldsw + _i * 8192), 16, 0, 0); } while (0)
#define PG8_LDA(dst, b, h) do { _Pragma("unroll") for (int m = 0; m < 4; ++m) _Pragma("unroll") for (int k = 0; k < 2; ++k) dst[m][k] = *(const PG8_LAS bf16x8*)(lds + PG8_SA(b, h) + aoff + m * 2048 + k * 1024); } while (0)
#define PG8_LDB(dst, b, h) do { _Pragma("unroll") for (int n = 0; n < 2; ++n) _Pragma("unroll") for (int k = 0; k < 2; ++k) dst[n][k] = *(const PG8_LAS bf16x8*)(lds + PG8_SB(b, h) + boff + n * 2048 + k * 1024); } while (0)
#define PG8_MMA(ai, bj, At, Bt) do { __builtin_amdgcn_s_setprio(1); _Pragma("unroll") for (int m = 0; m < 4; ++m) _Pragma("unroll") for (int n = 0; n < 2; ++n) _Pragma("unroll") for (int k = 0; k < 2; ++k) \
        acc[ai][bj][m][n] = __builtin_amdgcn_mfma_f32_16x16x32_bf16(Bt[n][k], At[m][k], acc[ai][bj][m][n], 0, 0, 0); __builtin_amdgcn_s_setprio(0); } while (0)
#define PG8_WAIT_V(n) asm volatile("s_waitcnt vmcnt(" #n ")" ::: "memory")
#define PG8_WAIT_L(n) asm volatile("s_waitcnt lgkmcnt(" #n ")" ::: "memory")
#define PG8_BAR __builtin_amdgcn_s_barrier()
#define PG8_SCHED __builtin_amdgcn_sched_barrier(0)
    Unit cur, nxt; int ui = 0;
    if (!S.next(0, cur)) return;
    f32x4 acc[2][2][4][2];
#pragma unroll
    for (int a = 0; a < 2; ++a)
#pragma unroll
        for (int b = 0; b < 2; ++b)
#pragma unroll
            for (int m = 0; m < 4; ++m)
#pragma unroll
                for (int n = 0; n < 2; ++n) acc[a][b][m][n] = (f32x4){0.f, 0.f, 0.f, 0.f};
    bf16x8 At[4][2], B0[2][2], B1[2][2];
    const char* cA = (const char*)(cur.z ? g.A2 : g.A) + (size_t)cur.pm * tstep; const char* cB = (const char*)(cur.z ? g.Bt2 : g.Bt) + (size_t)cur.pn * tstep;
    S.a_ready(cur);
    if constexpr (SP2) {
        PG8_STAGE(PG8_SB(0, 0), cB, voffB); PG8_STAGE(PG8_SB(0, 1), cB + hstep, voffB); PG8_STAGE(PG8_SA(0, 0), cA, voffA); PG8_STAGE(PG8_SA(0, 1), cA + hstep, voffA);
        if (wr == 1) PG8_BAR;
        PG8_WAIT_V(2); PG8_BAR;
        PG8_STAGE(PG8_SB(1, 0), cB + kstep, voffB); PG8_STAGE(PG8_SA(1, 0), cA + kstep, voffA); PG8_STAGE(PG8_SB(1, 1), cB + hstep + kstep, voffB);
        PG8_WAIT_V(6); PG8_BAR;
    } else {
        PG8_STAGE(PG8_SB(0, 0), cB, voffB); PG8_STAGE(PG8_SA(0, 0), cA, voffA); PG8_STAGE(PG8_SB(0, 1), cB + hstep, voffB); PG8_STAGE(PG8_SA(0, 1), cA + hstep, voffA);
        if (wr == 1) PG8_BAR;
        PG8_WAIT_V(4); PG8_BAR;
        PG8_STAGE(PG8_SB(1, 0), cB + kstep, voffB); PG8_STAGE(PG8_SA(1, 0), cA + kstep, voffA); PG8_STAGE(PG8_SB(1, 1), cB + hstep + kstep, voffB);
        PG8_WAIT_V(6); PG8_BAR;
    }
    for (;;) {
        const bool has_next = S.next(ui + 1, nxt);
        const char* nA = has_next ? (const char*)(nxt.z ? g.A2 : g.A) + (size_t)nxt.pm * tstep : cA; const char* nB = has_next ? (const char*)(nxt.z ? g.Bt2 : g.Bt) + (size_t)nxt.pn * tstep : cB;
        for (int t = 0; t < nt; t += 2) {
            const bool last = (t == nt - 2);
            const char* a1 = cA + (size_t)(t + 1) * kstep;
            const char* a2 = last ? nA : cA + (size_t)(t + 2) * kstep; const char* b2 = last ? nB : cB + (size_t)(t + 2) * kstep;
            const char* a3 = a2 + kstep; const char* b3 = b2 + kstep;
            if (last && has_next) S.a_ready(nxt);
            if constexpr (SP2) {
            PG8_LDB(B0, 0, 0); PG8_LDB(B1, 0, 1); PG8_SCHED; PG8_LDA(At, 0, 0); PG8_STAGE(PG8_SA(1, 1), a1 + hstep, voffA);
            PG8_WAIT_V(8); PG8_WAIT_L(0); PG8_BAR; PG8_MMA(0, 0, At, B0); PG8_MMA(0, 1, At, B1); PG8_BAR; PG8_SCHED;
            PG8_LDA(At, 0, 1); PG8_STAGE(PG8_SB(0, 0), b2, voffB); PG8_STAGE(PG8_SB(0, 1), b2 + hstep, voffB); PG8_STAGE(PG8_SA(0, 0), a2, voffA);
            PG8_WAIT_V(8); PG8_WAIT_L(0); PG8_BAR; PG8_MMA(1, 0, At, B0); PG8_MMA(1, 1, At, B1); PG8_BAR; PG8_SCHED;
            PG8_LDB(B0, 1, 0); PG8_LDB(B1, 1, 1); PG8_SCHED; PG8_LDA(At, 1, 0); PG8_STAGE(PG8_SA(0, 1), a2 + hstep, voffA);
            PG8_WAIT_V(8); PG8_WAIT_L(0); PG8_BAR; PG8_MMA(0, 0, At, B0); PG8_MMA(0, 1, At, B1); PG8_BAR; PG8_SCHED;
            PG8_LDA(At, 1, 1); PG8_STAGE(PG8_SB(1, 0), b3, voffB); PG8_STAGE(PG8_SB(1, 1), b3 + hstep, voffB); PG8_STAGE(PG8_SA(1, 0), a3, voffA);
            PG8_WAIT_V(8); PG8_WAIT_L(0); PG8_BAR; PG8_MMA(1, 0, At, B0); PG8_MMA(1, 1, At, B1); PG8_BAR; PG8_SCHED;
            } else {
            PG8_LDB(B0, 0, 0); PG8_SCHED; PG8_LDA(At, 0, 0); PG8_STAGE(PG8_SA(1, 1), a1 + hstep, voffA);
            PG8_WAIT_L(8); PG8_BAR; PG8_WAIT_L(0); PG8_MMA(0, 0, At, B0); PG8_BAR; PG8_SCHED;
            PG8_LDB(B1, 0, 1); PG8_STAGE(PG8_SB(0, 0), b2, voffB);
            PG8_BAR; PG8_WAIT_L(0); PG8_MMA(0, 1, At, B1); PG8_BAR;
            PG8_LDA(At, 0, 1); PG8_STAGE(PG8_SA(0, 0), a2, voffA);
            PG8_BAR; PG8_WAIT_L(0); PG8_MMA(1, 0, At, B0); PG8_BAR; PG8_SCHED;
            PG8_STAGE(PG8_SB(0, 1), b2 + hstep, voffB);
            PG8_WAIT_V(6); PG8_BAR; PG8_MMA(1, 1, At, B1); PG8_BAR;
            PG8_LDB(B0, 1, 0); PG8_SCHED; PG8_LDA(At, 1, 0); PG8_STAGE(PG8_SA(0, 1), a2 + hstep, voffA);
            PG8_WAIT_L(8); PG8_BAR; PG8_WAIT_L(0); PG8_MMA(0, 0, At, B0); PG8_BAR; PG8_SCHED;
            PG8_LDB(B1, 1, 1); PG8_STAGE(PG8_SB(1, 0), b3, voffB);
            PG8_BAR; PG8_WAIT_L(0); PG8_MMA(0, 1, At, B1); PG8_BAR;
            PG8_LDA(At, 1, 1); PG8_STAGE(PG8_SA(1, 0), a3, voffA);
            PG8_BAR; PG8_WAIT_L(0); PG8_MMA(1, 0, At, B0); PG8_BAR; PG8_SCHED;
            PG8_STAGE(PG8_SB(1, 1), b3 + hstep, voffB);
            PG8_WAIT_V(6); PG8_BAR; PG8_MMA(1, 1, At, B1); PG8_BAR;
            }
        }
        if constexpr (ALIGN_EPI) { if (wr == 0) PG8_BAR; }
        if constexpr (!Epi::AFTER_DRAIN) { if constexpr (Epi::DUAL || Epi::MUT) E.dual(acc, cur, wr, wc, fr, fq); else E(acc, cur, wr, wc, fr, fq); S.done(cur); }
        if (!has_next) break;
        if (!(Epi::DUAL && cur.z == 0))
#pragma unroll
        for (int a = 0; a < 2; ++a)
#pragma unroll
            for (int b = 0; b < 2; ++b)
#pragma unroll
                for (int m = 0; m < 4; ++m)
#pragma unroll
                    for (int n = 0; n < 2; ++n) acc[a][b][m][n] = (f32x4){0.f, 0.f, 0.f, 0.f};
        cur = nxt; cA = nA; cB = nB; ++ui;
        if constexpr (ALIGN_EPI) { if (wr == 1) PG8_BAR; }
    }
    PG8_WAIT_V(0);
    if constexpr (!ALIGN_EPI) { if (wr == 0) PG8_BAR; }
    PG8_BAR;
    if constexpr (Epi::AFTER_DRAIN) { E.fused(acc, cur, wr, wc, fr, fq, lds, wid, lane); S.done(cur); }
#undef PG8_SA
#undef PG8_SB
#undef PG8_STAGE
#undef PG8_LDA
#undef PG8_LDB
#undef PG8_MMA
#undef PG8_WAIT_V
#undef PG8_WAIT_L
#undef PG8_BAR
#undef PG8_SCHED
}
}

#define LAS __attribute__((address_space(3)))
typedef unsigned short bf16;
typedef float f32x4 __attribute__((ext_vector_type(4)));
typedef float f32x2 __attribute__((ext_vector_type(2)));
typedef short bf16x8 __attribute__((ext_vector_type(8)));
typedef short s16x4 __attribute__((ext_vector_type(4)));
typedef unsigned u32x4 __attribute__((ext_vector_type(4)));
typedef unsigned u32x2 __attribute__((ext_vector_type(2)));

constexpr int DM = 2048, NB = 8, SEQ = 2048, MT = NB * SEQ, DIN = 16416, DFF = 8192, NMOD = 6 * DM;
constexpr int N1A = 12288, N1B = 4096;
constexpr float EPS = 1e-6f;
constexpr size_t MiB = 1u << 20;
constexpr size_t WS_MODP = 0, WS_WINLO = 12 * MiB, WS_OA = 0, WS_WINHI = 64 * MiB, WS_MOD = 80 * MiB, WS_SMALL = 81 * MiB, WS_CTL = 83 * MiB, WS_ROWSS = 83 * MiB + 65536, WS_PCNT = 83 * MiB + 196608, WS_ROWSS2 = 83 * MiB + 131072, WS_PCNT2 = 83 * MiB + 212992;
constexpr size_t WS_WA = 84 * MiB, WS_WB = 92 * MiB, WS_WO = 100 * MiB;
constexpr size_t WS_GQ = 108 * MiB, WS_GK = 140 * MiB, WS_GVT = 172 * MiB, WS_GG = 236 * MiB, WS_FQ = 300 * MiB, WS_FK = 364 * MiB, WS_FVT = 428 * MiB, WS_KDTG = 492 * MiB, WS_EBLG = 524 * MiB, WS_CUMG = 525 * MiB, WS_END = 526 * MiB;
constexpr size_t WS_SGA = 108 * MiB, WS_SGB = 300 * MiB, WS_W1 = 172 * MiB, WS_W2 = 204 * MiB, WS_T = 364 * MiB, WS_MG = 236 * MiB, WS_H2 = 108 * MiB, WS_U = 236 * MiB, WS_X2B = 108 * MiB, WS_X1B = 0;
constexpr int LDS_BYTES = 150 * 1024;

struct Args { const float* in[17]; float* out; unsigned char* ws; };

__device__ __forceinline__ unsigned f2bf(float f) { unsigned u = __builtin_bit_cast(unsigned, f); return (u + 0x7fffu + ((u >> 16) & 1u)) >> 16; }
typedef __bf16 bf16x2_t __attribute__((ext_vector_type(2)));
__device__ __forceinline__ unsigned pk2(float lo, float hi) { const f32x2 v = {lo, hi}; const bf16x2_t b = __builtin_convertvector(v, bf16x2_t); return __builtin_bit_cast(unsigned, b); }
__device__ __forceinline__ float bf2f(unsigned short v) { return __builtin_bit_cast(float, (unsigned)v << 16); }
__device__ __forceinline__ float bflo(unsigned w) { return __builtin_bit_cast(float, w << 16); }
__device__ __forceinline__ float bfhi(unsigned w) { return __builtin_bit_cast(float, w & 0xffff0000u); }
__device__ __forceinline__ float shx(float v, int o, int lane) { return __builtin_bit_cast(float, __builtin_amdgcn_ds_bpermute((lane ^ o) << 2, __builtin_bit_cast(int, v))); }
__device__ __forceinline__ float wave_sum(float v, int lane) {
#pragma unroll
    for (int o = 1; o < 64; o <<= 1) v += shx(v, o, lane);
    return v;
}
__device__ __forceinline__ float logsig(float z) { return fminf(z, 0.f) - __logf(1.f + __expf(-fabsf(z))); }
__device__ __forceinline__ float sigmoidf_(float z) { return __builtin_amdgcn_rcpf(1.f + __expf(-z)); }
template <int CTRL> __device__ __forceinline__ unsigned dppu(unsigned x) { return (unsigned)__builtin_amdgcn_mov_dpp((int)x, CTRL, 0xF, 0xF, true); }
template <int CTRL> __device__ __forceinline__ float dppx(float x) { return __builtin_bit_cast(float, __builtin_amdgcn_mov_dpp(__builtin_bit_cast(int, x), CTRL, 0xF, 0xF, true)); }
#define LDS_WAIT() asm volatile("s_waitcnt lgkmcnt(0)" ::: "memory")

struct EpiProj {
    static constexpr bool PERM = true, AFTER_DRAIN = false, DUAL = false, MUT = false;
    unsigned char* ws;
    __device__ __forceinline__ void operator()(const f32x4 (&acc)[2][2][4][2], const pg8::Unit& u, int wr, int wc, int fr, int fq) const {
        const int pn = u.pn, row0 = u.pm * 256 + wr * 64 + fr, cin = wc * 32 + 8 * fq;
        if (pn == 48) {
            if (wc == 0) { float* S = (float*)(ws + WS_SMALL);
#pragma unroll
                for (int ai = 0; ai < 2; ++ai)
#pragma unroll
                    for (int m = 0; m < 4; ++m) { float* p = S + (size_t)(row0 + ai * 128 + m * 16) * 32 + 8 * fq; *(f32x4*)p = acc[ai][0][m][0]; *(f32x4*)(p + 4) = acc[ai][0][m][1]; } }
            return;
        }
        const bool tr = (pn >= 8 && pn < 16) || pn >= 40;
        if (!tr) {
            bf16* base; int ld, c0;
            if (pn < 4) { base = (bf16*)(ws + WS_GQ); ld = 1024; c0 = pn * 256; }
            else if (pn < 8) { base = (bf16*)(ws + WS_GK); ld = 1024; c0 = (pn - 4) * 256; }
            else if (pn < 24) { base = (bf16*)(ws + WS_GG); ld = 2048; c0 = (pn - 16) * 256; }
            else if (pn < 32) { base = (bf16*)(ws + WS_FQ); ld = 2048; c0 = (pn - 24) * 256; }
            else { base = (bf16*)(ws + WS_FK); ld = 2048; c0 = (pn - 32) * 256; }
#pragma unroll
            for (int ai = 0; ai < 2; ++ai)
#pragma unroll
                for (int m = 0; m < 4; ++m) { bf16* rp = base + (size_t)(row0 + ai * 128 + m * 16) * ld + c0 + cin;
#pragma unroll
                    for (int bj = 0; bj < 2; ++bj) { const f32x4 v0 = acc[ai][bj][m][0], v1 = acc[ai][bj][m][1];
                        u32x4 w; w.x = pk2(v0[0], v0[1]); w.y = pk2(v0[2], v0[3]); w.z = pk2(v1[0], v1[1]); w.w = pk2(v1[2], v1[3]);
                        *(u32x4*)(rp + bj * 128) = w; } }
        } else {
            bf16* base = (bf16*)(ws + (pn < 16 ? WS_GVT : WS_FVT)); const int c0 = (pn < 16 ? pn - 8 : pn - 40) * 256;
            const int b = (u.pm * 256) / SEQ, blk0 = ((u.pm * 256) % SEQ) / 64 + wr, jq = fr & 3;
            const bool b0 = (jq & 1) != 0, b1 = (jq & 2) != 0;
            const int sn = 16 * jq + 4 * (fr >> 2); const int s = pn < 16 ? sn : ((sn & ~31) | (((sn >> 2) & 3) << 3) | (((sn >> 4) & 1) << 2));
            bf16* bb = base + (((size_t)b * 32 + blk0) * DM + c0 + cin) * 64 + s;
#pragma unroll
            for (int ai = 0; ai < 2; ++ai)
#pragma unroll
                for (int bj = 0; bj < 2; ++bj)
#pragma unroll
                    for (int n = 0; n < 2; ++n) { unsigned wx[4], wy[4];
#pragma unroll
                        for (int m = 0; m < 4; ++m) { float r0 = acc[ai][bj][m][n][0], r1 = acc[ai][bj][m][n][1], r2 = acc[ai][bj][m][n][2], r3 = acc[ai][bj][m][n][3];
                            { const float x = b0 ? r0 : r1, y = dppx<0xB1>(x); if (b0) r0 = y; else r1 = y; }
                            { const float x = b0 ? r2 : r3, y = dppx<0xB1>(x); if (b0) r2 = y; else r3 = y; }
                            { const float x = b1 ? r0 : r2, y = dppx<0x4E>(x); if (b1) r0 = y; else r2 = y; }
                            { const float x = b1 ? r1 : r3, y = dppx<0x4E>(x); if (b1) r1 = y; else r3 = y; }
                            wx[m] = pk2(r0, r1); wy[m] = pk2(r2, r3); }
                        { const unsigned x = b0 ? wx[0] : wx[1], y = dppu<0xB1>(x); if (b0) wx[0] = y; else wx[1] = y; }
                        { const unsigned x = b0 ? wx[2] : wx[3], y = dppu<0xB1>(x); if (b0) wx[2] = y; else wx[3] = y; }
                        { const unsigned x = b1 ? wx[0] : wx[2], y = dppu<0x4E>(x); if (b1) wx[0] = y; else wx[2] = y; }
                        { const unsigned x = b1 ? wx[1] : wx[3], y = dppu<0x4E>(x); if (b1) wx[1] = y; else wx[3] = y; }
                        { const unsigned x = b0 ? wy[0] : wy[1], y = dppu<0xB1>(x); if (b0) wy[0] = y; else wy[1] = y; }
                        { const unsigned x = b0 ? wy[2] : wy[3], y = dppu<0xB1>(x); if (b0) wy[2] = y; else wy[3] = y; }
                        { const unsigned x = b1 ? wy[0] : wy[2], y = dppu<0x4E>(x); if (b1) wy[0] = y; else wy[2] = y; }
                        { const unsigned x = b1 ? wy[1] : wy[3], y = dppu<0x4E>(x); if (b1) wy[1] = y; else wy[3] = y; }
#pragma unroll
                        for (int mc = 0; mc < 4; ++mc) { u32x2 w; w.x = wx[mc]; w.y = wy[mc];
                            *(u32x2*)(bb + ((size_t)(2 * ai) * DM + bj * 128 + 4 * n + mc) * 64) = w; } }
        }
    }
};
template <int MODE> struct EpiGen {
    static constexpr bool PERM = true, AFTER_DRAIN = false, DUAL = false, MUT = false;
    bf16* ob; int ldo; const bf16* gb; float* tf; const float* xin; float* xout; const float* gate;
    __device__ __forceinline__ void operator()(const f32x4 (&acc)[2][2][4][2], const pg8::Unit& u, int wr, int wc, int fr, int fq) const {
        const int row0 = u.pm * 256 + wr * 64 + fr; int col0 = u.pn * 256 + wc * 32 + 8 * fq;
        bf16* obase = ob;
        if (MODE == 0) { if (u.pn >= 8) { obase = (bf16*)((unsigned char*)ob + (WS_SGB - WS_SGA)); col0 -= 2048; } }
        f32x4 g0[2], g1[2];
        if (MODE == 3 || MODE == 5 || MODE == 6) { const float* gp = gate + (size_t)((u.pm * 256) / SEQ) * NMOD + col0;
#pragma unroll
            for (int bj = 0; bj < 2; ++bj) { g0[bj] = *(const f32x4*)(gp + bj * 128); g1[bj] = *(const f32x4*)(gp + bj * 128 + 4); } }
#pragma unroll
        for (int aq = 0; aq < 4; ++aq) { const int ai = aq >> 1, mh = aq & 1;
            u32x4 gw[2][2]; f32x4 p0[2][2], p1[2][2];
            if (MODE == 1 || MODE == 2 || MODE == 3 || MODE == 5 || MODE == 6) {
#pragma unroll
                for (int m2 = 0; m2 < 2; ++m2) { const size_t row = (size_t)(row0 + ai * 128 + (2 * mh + m2) * 16);
#pragma unroll
                    for (int bj = 0; bj < 2; ++bj) { const int col = col0 + bj * 128;
                        if (MODE == 1 || MODE == 2 || MODE == 6) gw[m2][bj] = *(const u32x4*)(gb + row * 2048 + col);
                        if (MODE == 2) { p0[m2][bj] = *(const f32x4*)(tf + row * 2048 + col); p1[m2][bj] = *(const f32x4*)(tf + row * 2048 + col + 4); }
                        if (MODE == 3 || MODE == 5) { p0[m2][bj] = *(const f32x4*)(xin + row * 2048 + col); p1[m2][bj] = *(const f32x4*)(xin + row * 2048 + col + 4); } } }
                __builtin_amdgcn_sched_barrier(0); }
#pragma unroll
            for (int m2 = 0; m2 < 2; ++m2) { const int m = 2 * mh + m2; const size_t row = (size_t)(row0 + ai * 128 + m * 16);
#pragma unroll
                for (int bj = 0; bj < 2; ++bj) { f32x4 v0 = acc[ai][bj][m][0], v1 = acc[ai][bj][m][1]; const int col = col0 + bj * 128;
                    if (MODE == 0) {
#pragma unroll
                        for (int e = 0; e < 4; ++e) { v0[e] = sigmoidf_(v0[e]); v1[e] = sigmoidf_(v1[e]); }
                        u32x4 w; w.x = pk2(v0[0], v0[1]); w.y = pk2(v0[2], v0[3]); w.z = pk2(v1[0], v1[1]); w.w = pk2(v1[2], v1[3]);
                        *(u32x4*)(obase + row * ldo + col) = w;
                    } else if (MODE == 1 || MODE == 2) {
                        const u32x4 g = gw[m2][bj];
                        const f32x4 s0 = {bflo(g.x), bfhi(g.x), bflo(g.y), bfhi(g.y)}, s1 = {bflo(g.z), bfhi(g.z), bflo(g.w), bfhi(g.w)};
                        float* tp = tf + row * 2048 + col;
                        if (MODE == 1) { *(f32x4*)tp = s0 * v0; *(f32x4*)(tp + 4) = s1 * v1; }
                        else { v0 = p0[m2][bj] + s0 * v0; v1 = p1[m2][bj] + s1 * v1;
                            u32x4 w; w.x = pk2(v0[0], v0[1]); w.y = pk2(v0[2], v0[3]); w.z = pk2(v1[0], v1[1]); w.w = pk2(v1[2], v1[3]);
                            *(u32x4*)(obase + row * ldo + col) = w; }
                    } else if (MODE == 3) {
                        float* op = xout + row * 2048 + col;
                        *(f32x4*)op = p0[m2][bj] + g0[bj] * v0; *(f32x4*)(op + 4) = p1[m2][bj] + g1[bj] * v1;
                    } else if (MODE == 5 || MODE == 6) {
                        f32x4 x0, x1;
                        if (MODE == 5) { x0 = p0[m2][bj]; x1 = p1[m2][bj]; }
                        else { const u32x4 g = gw[m2][bj]; x0 = (f32x4){bflo(g.x), bfhi(g.x), bflo(g.y), bfhi(g.y)}; x1 = (f32x4){bflo(g.z), bfhi(g.z), bflo(g.w), bfhi(g.w)}; }
                        v0 = x0 + g0[bj] * v0; v1 = x1 + g1[bj] * v1;
                        u32x4 w; w.x = pk2(v0[0], v0[1]); w.y = pk2(v0[2], v0[3]); w.z = pk2(v1[0], v1[1]); w.w = pk2(v1[2], v1[3]);
                        *(u32x4*)(obase + row * ldo + col) = w;
                    } else {
#pragma unroll
                        for (int e = 0; e < 4; ++e) { const float a = fmaxf(v0[e], 0.f), c = fmaxf(v1[e], 0.f); v0[e] = a * a; v1[e] = c * c; }
                        u32x4 w; w.x = pk2(v0[0], v0[1]); w.y = pk2(v0[2], v0[3]); w.z = pk2(v1[0], v1[1]); w.w = pk2(v1[2], v1[3]);
                        *(u32x4*)(obase + row * ldo + col) = w;
                    } } }
            if (MODE == 1 || MODE == 2 || MODE == 3 || MODE == 5 || MODE == 6) __builtin_amdgcn_sched_barrier(0); }
    }
};

struct EpiDual {
    static constexpr bool PERM = true, AFTER_DRAIN = false, DUAL = true, MUT = false;
    bf16* mg; const bf16* sga; const bf16* sgb;
    __device__ __forceinline__ void dual(f32x4 (&acc)[2][2][4][2], const pg8::Unit& u, int wr, int wc, int fr, int fq) const {
        const int row0 = u.pm * 256 + wr * 64 + fr, col0 = u.pn * 256 + wc * 32 + 8 * fq; const bool first = (u.z == 0);
#pragma unroll
        for (int aq = 0; aq < 4; ++aq) { const int ai = aq >> 1, mh = aq & 1;
            u32x4 ga[2][2], gbv[2][2];
#pragma unroll
            for (int m2 = 0; m2 < 2; ++m2) { const size_t row = (size_t)(row0 + ai * 128 + (2 * mh + m2) * 16);
#pragma unroll
                for (int bj = 0; bj < 2; ++bj) { const int col = col0 + bj * 128; gbv[m2][bj] = *(const u32x4*)(sgb + row * 2048 + col); if (first) ga[m2][bj] = *(const u32x4*)(sga + row * 2048 + col); else ga[m2][bj] = (u32x4){0u, 0u, 0u, 0u}; } }
            __builtin_amdgcn_sched_barrier(0);
#pragma unroll
            for (int m2 = 0; m2 < 2; ++m2) { const int m = 2 * mh + m2; const size_t row = (size_t)(row0 + ai * 128 + m * 16);
#pragma unroll
                for (int bj = 0; bj < 2; ++bj) { const u32x4 gB = gbv[m2][bj], gA = ga[m2][bj]; const int col = col0 + bj * 128;
                    f32x4 b0 = {bflo(gB.x), bfhi(gB.x), bflo(gB.y), bfhi(gB.y)}, b1 = {bflo(gB.z), bfhi(gB.z), bflo(gB.w), bfhi(gB.w)};
#pragma unroll
                    for (int e = 0; e < 4; ++e) { b0[e] = fmaxf(b0[e], 1e-30f); b1[e] = fmaxf(b1[e], 1e-30f); }
                    if (first) {
                        const f32x4 a0 = {bflo(gA.x), bfhi(gA.x), bflo(gA.y), bfhi(gA.y)}, a1 = {bflo(gA.z), bfhi(gA.z), bflo(gA.w), bfhi(gA.w)};
#pragma unroll
                        for (int e = 0; e < 4; ++e) { acc[ai][bj][m][0][e] *= a0[e] * __builtin_amdgcn_rcpf(b0[e]); acc[ai][bj][m][1][e] *= a1[e] * __builtin_amdgcn_rcpf(b1[e]); }
                    } else {
                        const f32x4 v0 = acc[ai][bj][m][0] * b0, v1 = acc[ai][bj][m][1] * b1;
                        u32x4 w; w.x = pk2(v0[0], v0[1]); w.y = pk2(v0[2], v0[3]); w.z = pk2(v1[0], v1[1]); w.w = pk2(v1[2], v1[3]);
                        *(u32x4*)(mg + row * 2048 + col) = w; } } }
            __builtin_amdgcn_sched_barrier(0); }
    }
    __device__ __forceinline__ void operator()(const f32x4 (&)[2][2][4][2], const pg8::Unit&, int, int, int, int) const {}
};

struct EpiFinal {
    static constexpr bool PERM = true, AFTER_DRAIN = false, DUAL = false, MUT = true;
    float* out; const bf16* x1b; const float* gate; const float* gfin; float* rowss; unsigned* pcnt; LAS float* scr;
    __device__ __forceinline__ void dual(f32x4 (&acc)[2][2][4][2], const pg8::Unit& u, int wr, int wc, int fr, int fq) const {
        const int row0 = u.pm * 256 + wr * 64 + fr, col0 = u.pn * 256 + wc * 32 + 8 * fq, lane = fr + 16 * fq;
        f32x4 g0[2], g1[2];
        { const float* gp = gate + (size_t)((u.pm * 256) / SEQ) * NMOD + col0;
#pragma unroll
          for (int bj = 0; bj < 2; ++bj) { g0[bj] = *(const f32x4*)(gp + bj * 128); g1[bj] = *(const f32x4*)(gp + bj * 128 + 4); } }
        float ssq[2][4];
#pragma unroll
        for (int aq = 0; aq < 4; ++aq) { const int ai = aq >> 1, mh = aq & 1; u32x4 gw[2][2];
#pragma unroll
            for (int m2 = 0; m2 < 2; ++m2)
#pragma unroll
                for (int bj = 0; bj < 2; ++bj) gw[m2][bj] = *(const u32x4*)(x1b + (size_t)(row0 + ai * 128 + (2 * mh + m2) * 16) * 2048 + col0 + bj * 128);
            __builtin_amdgcn_sched_barrier(0);
#pragma unroll
            for (int m2 = 0; m2 < 2; ++m2) { const int m = 2 * mh + m2; float ss = 0.f;
#pragma unroll
                for (int bj = 0; bj < 2; ++bj) { const u32x4 g = gw[m2][bj];
                    const f32x4 x0 = {bflo(g.x), bfhi(g.x), bflo(g.y), bfhi(g.y)}, x1 = {bflo(g.z), bfhi(g.z), bflo(g.w), bfhi(g.w)};
                    const f32x4 v0 = x0 + g0[bj] * acc[ai][bj][m][0], v1 = x1 + g1[bj] * acc[ai][bj][m][1];
                    acc[ai][bj][m][0] = v0; acc[ai][bj][m][1] = v1;
                    ss += (v0[0] * v0[0] + v0[1] * v0[1]) + (v0[2] * v0[2] + v0[3] * v0[3]) + (v1[0] * v1[0] + v1[1] * v1[1]) + (v1[2] * v1[2] + v1[3] * v1[3]); }
                ss += shx(ss, 16, lane); ss += shx(ss, 32, lane); ssq[ai][m] = ss; }
            __builtin_amdgcn_sched_barrier(0); }
        if (fq == 0) {
#pragma unroll
            for (int ai = 0; ai < 2; ++ai)
#pragma unroll
                for (int m = 0; m < 4; ++m) scr[(wr * 64 + ai * 128 + m * 16 + fr) * 4 + wc] = ssq[ai][m]; }
        asm volatile("s_waitcnt lgkmcnt(0)" ::: "memory"); __builtin_amdgcn_s_barrier(); asm volatile("" ::: "memory");
        const int tid = (wr * 4 + wc) * 64 + lane;
        if (tid < 256) { const f32x4 q4 = *(const LAS f32x4*)(scr + tid * 4);
            __hip_atomic_fetch_add(rowss + u.pm * 256 + tid, (q4[0] + q4[1]) + (q4[2] + q4[3]), __ATOMIC_RELAXED, __HIP_MEMORY_SCOPE_AGENT); }
        asm volatile("s_waitcnt vmcnt(0) lgkmcnt(0)" ::: "memory"); __builtin_amdgcn_s_barrier(); asm volatile("" ::: "memory");
        unsigned* pc = pcnt + 64 * u.pm;
        if (tid == 0) __hip_atomic_fetch_add(pc, 1u, __ATOMIC_RELAXED, __HIP_MEMORY_SCOPE_AGENT);
        if (tid < 64) { unsigned spins = 0; while (__hip_atomic_load(pc, __ATOMIC_RELAXED, __HIP_MEMORY_SCOPE_AGENT) < 8u) { __builtin_amdgcn_s_sleep(1); if (++spins > (1u << 20)) break; } }
        asm volatile("s_waitcnt vmcnt(0) lgkmcnt(0)" ::: "memory"); __builtin_amdgcn_s_barrier(); asm volatile("" ::: "memory");
        asm volatile("" ::: "memory");
#pragma unroll
        for (int ai = 0; ai < 2; ++ai)
#pragma unroll
            for (int m = 0; m < 4; ++m) { const size_t row = (size_t)(row0 + ai * 128 + m * 16);
                const float tot = __hip_atomic_load(rowss + row, __ATOMIC_RELAXED, __HIP_MEMORY_SCOPE_AGENT);
                const float rstd = rsqrtf(tot * (1.f / DM) + EPS);
#pragma unroll
                for (int bj = 0; bj < 2; ++bj) { const int col = col0 + bj * 128; const f32x4 f0 = *(const f32x4*)(gfin + col), f1 = *(const f32x4*)(gfin + col + 4);
                    float* op = out + row * 2048 + col;
                    *(f32x4*)op = acc[ai][bj][m][0] * rstd * f0; *(f32x4*)(op + 4) = acc[ai][bj][m][1] * rstd * f1; } }
    }
    __device__ __forceinline__ void operator()(const f32x4 (&)[2][2][4][2], const pg8::Unit&, int, int, int, int) const {}
};
struct EpiMid {
    static constexpr bool PERM = true, AFTER_DRAIN = false, DUAL = false, MUT = true;
    bf16* x1b; bf16* h2; const float* xin; const float* mod; const float* g2; float* rowss; unsigned* pcnt; LAS float* scr;
    __device__ __forceinline__ void dual(f32x4 (&acc)[2][2][4][2], const pg8::Unit& u, int wr, int wc, int fr, int fq) const {
        const int row0 = u.pm * 256 + wr * 64 + fr, col0 = u.pn * 256 + wc * 32 + 8 * fq, lane = fr + 16 * fq;
        const float* mb = mod + (size_t)((u.pm * 256) / SEQ) * NMOD;
        f32x4 g0[2], g1[2];
#pragma unroll
        for (int bj = 0; bj < 2; ++bj) { g0[bj] = *(const f32x4*)(mb + 2 * DM + col0 + bj * 128); g1[bj] = *(const f32x4*)(mb + 2 * DM + col0 + bj * 128 + 4); }
        float ssq[2][4];
#pragma unroll
        for (int aq = 0; aq < 4; ++aq) { const int ai = aq >> 1, mh = aq & 1; f32x4 p0[2][2], p1[2][2];
#pragma unroll
            for (int m2 = 0; m2 < 2; ++m2)
#pragma unroll
                for (int bj = 0; bj < 2; ++bj) { const float* xp = xin + (size_t)(row0 + ai * 128 + (2 * mh + m2) * 16) * 2048 + col0 + bj * 128; p0[m2][bj] = *(const f32x4*)xp; p1[m2][bj] = *(const f32x4*)(xp + 4); }
            __builtin_amdgcn_sched_barrier(0);
#pragma unroll
            for (int m2 = 0; m2 < 2; ++m2) { const int m = 2 * mh + m2; float ss = 0.f; const size_t row = (size_t)(row0 + ai * 128 + m * 16);
#pragma unroll
                for (int bj = 0; bj < 2; ++bj) {
                    const f32x4 v0 = p0[m2][bj] + g0[bj] * acc[ai][bj][m][0], v1 = p1[m2][bj] + g1[bj] * acc[ai][bj][m][1];
                    acc[ai][bj][m][0] = v0; acc[ai][bj][m][1] = v1;
                    ss += (v0[0] * v0[0] + v0[1] * v0[1]) + (v0[2] * v0[2] + v0[3] * v0[3]) + (v1[0] * v1[0] + v1[1] * v1[1]) + (v1[2] * v1[2] + v1[3] * v1[3]);
                    u32x4 w; w.x = pk2(v0[0], v0[1]); w.y = pk2(v0[2], v0[3]); w.z = pk2(v1[0], v1[1]); w.w = pk2(v1[2], v1[3]);
                    *(u32x4*)(x1b + row * 2048 + col0 + bj * 128) = w; }
                ss += shx(ss, 16, lane); ss += shx(ss, 32, lane); ssq[ai][m] = ss; }
            __builtin_amdgcn_sched_barrier(0); }
        if (fq == 0) {
#pragma unroll
            for (int ai = 0; ai < 2; ++ai)
#pragma unroll
                for (int m = 0; m < 4; ++m) scr[(wr * 64 + ai * 128 + m * 16 + fr) * 4 + wc] = ssq[ai][m]; }
        asm volatile("s_waitcnt lgkmcnt(0)" ::: "memory"); __builtin_amdgcn_s_barrier(); asm volatile("" ::: "memory");
        const int tid = (wr * 4 + wc) * 64 + lane;
        if (tid < 256) { const f32x4 q4 = *(const LAS f32x4*)(scr + tid * 4);
            __hip_atomic_fetch_add(rowss + u.pm * 256 + tid, (q4[0] + q4[1]) + (q4[2] + q4[3]), __ATOMIC_RELAXED, __HIP_MEMORY_SCOPE_AGENT); }
        asm volatile("s_waitcnt vmcnt(0) lgkmcnt(0)" ::: "memory"); __builtin_amdgcn_s_barrier(); asm volatile("" ::: "memory");
        unsigned* pc = pcnt + 64 * u.pm;
        if (tid == 0) __hip_atomic_fetch_add(pc, 1u, __ATOMIC_RELAXED, __HIP_MEMORY_SCOPE_AGENT);
        if (tid < 64) { unsigned spins = 0; while (__hip_atomic_load(pc, __ATOMIC_RELAXED, __HIP_MEMORY_SCOPE_AGENT) < 8u) { __builtin_amdgcn_s_sleep(1); if (++spins > (1u << 20)) break; } }
        asm volatile("s_waitcnt vmcnt(0) lgkmcnt(0)" ::: "memory"); __builtin_amdgcn_s_barrier(); asm volatile("" ::: "memory");
        asm volatile("" ::: "memory");
        float rs[2][4];
#pragma unroll
        for (int ai = 0; ai < 2; ++ai)
#pragma unroll
            for (int m = 0; m < 4; ++m) rs[ai][m] = rsqrtf(__hip_atomic_load(rowss + row0 + ai * 128 + m * 16, __ATOMIC_RELAXED, __HIP_MEMORY_SCOPE_AGENT) * (1.f / DM) + EPS);
#pragma unroll
        for (int bj = 0; bj < 2; ++bj) { const int col = col0 + bj * 128;
            const f32x4 ga = *(const f32x4*)(g2 + col), gb2 = *(const f32x4*)(g2 + col + 4);
            f32x4 sa = *(const f32x4*)(mb + 4 * DM + col), sb = *(const f32x4*)(mb + 4 * DM + col + 4); const f32x4 ha = *(const f32x4*)(mb + 3 * DM + col), hb = *(const f32x4*)(mb + 3 * DM + col + 4);
            sa = (sa + 1.f) * ga; sb = (sb + 1.f) * gb2;
#pragma unroll
            for (int ai = 0; ai < 2; ++ai)
#pragma unroll
                for (int m = 0; m < 4; ++m) { const size_t row = (size_t)(row0 + ai * 128 + m * 16); const float r = rs[ai][m];
                    const f32x4 o0 = acc[ai][bj][m][0] * r * sa + ha, o1 = acc[ai][bj][m][1] * r * sb + hb;
                    u32x4 w; w.x = pk2(o0[0], o0[1]); w.y = pk2(o0[2], o0[3]); w.z = pk2(o1[0], o1[1]); w.w = pk2(o1[2], o1[3]);
                    *(u32x4*)(h2 + row * 2048 + col) = w; } }
    }
    __device__ __forceinline__ void operator()(const f32x4 (&)[2][2][4][2], const pg8::Unit&, int, int, int, int) const {}
};
__device__ __forceinline__ int my_lane() { int l; asm volatile("v_mbcnt_lo_u32_b32 %0, -1, 0\n\tv_mbcnt_hi_u32_b32 %0, -1, %0" : "=v"(l)); return l; }

__device__ __forceinline__ void tr_item(const float* W, int ldw, int k0, int srccol, bf16* WT, int K, int dstrow0, LAS float* scr, int lane) {
    const int kr = lane >> 4, c4 = lane & 15;
    f32x4 v[16];
#pragma unroll
    for (int i = 0; i < 16; ++i) v[i] = srccol >= 0 ? *(const f32x4*)(W + (size_t)(k0 + kr + 4 * i) * ldw + srccol) : (f32x4){0.f, 0.f, 0.f, 0.f};
#pragma unroll
    for (int i = 0; i < 16; ++i) { LAS float* p = scr + (kr + 4 * i) * 65 + 4 * c4; p[0] = v[i][0]; p[1] = v[i][1]; p[2] = v[i][2]; p[3] = v[i][3]; }
    LDS_WAIT(); asm volatile("" ::: "memory");
    const int c = lane & 7;
#pragma unroll
    for (int j = 0; j < 8; ++j) { const int n = (lane >> 3) + 8 * j; const LAS float* s = scr + (8 * c) * 65 + n;
        u32x4 o; o.x = pk2(s[0 * 65], s[1 * 65]); o.y = pk2(s[2 * 65], s[3 * 65]); o.z = pk2(s[4 * 65], s[5 * 65]); o.w = pk2(s[6 * 65], s[7 * 65]);
        *(u32x4*)(WT + (size_t)(dstrow0 + n) * K + k0 + 8 * c) = o; }
    LDS_WAIT(); asm volatile("" ::: "memory");
}
__device__ __forceinline__ void tr_plain(const float* W, int K, int N, bf16* WT, int item, LAS float* scr, int lane) {
    const int nblk = N / 64, kb = item / nblk, nb = item % nblk;
    tr_item(W, N, 64 * kb, 64 * nb + 4 * (lane & 15), WT, K, 64 * nb, scr, lane);
}
__device__ __forceinline__ void p0_phase(const Args& a, LAS unsigned char* lds, int gw, int NGW, int wave, int lane) {
    LAS float* scr = (LAS float*)(lds + wave * 16896);
    unsigned char* ws = a.ws;
    constexpr int NDB = 193 + 64, I_IN = 32 * NDB, I_SQ = 32 * 32;
    for (int it = gw; it < I_IN + 3 * I_SQ; it += NGW) {
        if (it < I_IN) {
            const int kb = it / NDB, db = it % NDB;
            int dstrow0; bf16* WT;
            if (db < 193) { dstrow0 = 64 * db; WT = (bf16*)(ws + WS_WINLO); } else { dstrow0 = 64 * (db - 193); WT = (bf16*)(ws + WS_WINHI); }
            const int d = (db < 193 ? 64 * db : 12544 + 64 * (db - 193)) + 4 * (lane & 15);
            int src;
            if (d < 6144) src = d; else if (d < 12288) src = d + 16; else if (d < 12304) src = 6144 + (d - 12288); else if (d < 12320) src = d; else if (d < 12544) src = -1; else src = d - 224;
            tr_item(a.in[5], DIN, 64 * kb, src, WT, DM, dstrow0, scr, lane);
        } else {
            int r = it - I_IN;
            if (r < I_SQ) tr_plain(a.in[10], DM, DM, (bf16*)(ws + WS_WA), r, scr, lane);
            else if (r < 2 * I_SQ) tr_plain(a.in[11], DM, DM, (bf16*)(ws + WS_WB), r - I_SQ, scr, lane);
            else tr_plain(a.in[12], DM, DM, (bf16*)(ws + WS_WO), r - 2 * I_SQ, scr, lane);
        }
    }
    { u32x4* z = (u32x4*)(ws + WS_WINLO + (size_t)12352 * DM * 2); const int n16 = 192 * DM * 2 / 16;
      for (int i = gw * 64 + lane; i < n16; i += NGW * 64) z[i] = (u32x4){0u, 0u, 0u, 0u}; }
    const float* c = a.in[1]; const float* wada = a.in[2]; float* modp = (float*)(ws + WS_MODP);
    for (int it = gw; it < 32 * 48; it += NGW) {
        const int kc = it / 48, nb = it % 48, k0 = kc * 64;
#pragma unroll
        for (int b = 0; b < 8; ++b) { const float v = c[b * DM + k0 + lane]; scr[b * 64 + lane] = v * sigmoidf_(v); }
        LDS_WAIT(); asm volatile("" ::: "memory");
        f32x4 acc[8];
#pragma unroll
        for (int b = 0; b < 8; ++b) acc[b] = (f32x4){0.f, 0.f, 0.f, 0.f};
        const float* wp = wada + (size_t)k0 * NMOD + nb * 256 + lane * 4;
#pragma unroll 8
        for (int kk = 0; kk < 64; ++kk) { const f32x4 w = *(const f32x4*)(wp + (size_t)kk * NMOD);
#pragma unroll
            for (int b = 0; b < 8; ++b) acc[b] += w * scr[b * 64 + kk]; }
#pragma unroll
        for (int b = 0; b < 8; ++b) *(f32x4*)(modp + (size_t)(kc * 8 + b) * NMOD + nb * 256 + lane * 4) = acc[b];
        LDS_WAIT(); asm volatile("" ::: "memory");
    }
}

struct RowRegs { f32x4 v[8]; };
__device__ __forceinline__ void row_load(RowRegs& R, const float* xrow, int lane) {
#pragma unroll
    for (int j = 0; j < 8; ++j) R.v[j] = *(const f32x4*)(xrow + (j * 64 + lane) * 4);
}
__device__ __forceinline__ void row_load_b16(RowRegs& R, const bf16* xrow, int lane) {
#pragma unroll
    for (int j = 0; j < 4; ++j) { const u32x4 w = *(const u32x4*)(xrow + (j * 64 + lane) * 8);
        R.v[2 * j] = (f32x4){bflo(w.x), bfhi(w.x), bflo(w.y), bfhi(w.y)}; R.v[2 * j + 1] = (f32x4){bflo(w.z), bfhi(w.z), bflo(w.w), bfhi(w.w)}; }
}
template <bool SRC16> __device__ __forceinline__ int row_col(int j, int lane) { return SRC16 ? ((j >> 1) * 64 + lane) * 8 + (j & 1) * 4 : (j * 64 + lane) * 4; }
template <class SC, bool SRC16 = false>
__device__ __forceinline__ void norm_finish_bf16(const RowRegs& R, const float* g, SC scp, SC shp, bf16* orow, int lane) {
    float ss = 0.f;
#pragma unroll
    for (int j = 0; j < 8; ++j) ss += (R.v[j][0] * R.v[j][0] + R.v[j][1] * R.v[j][1]) + (R.v[j][2] * R.v[j][2] + R.v[j][3] * R.v[j][3]);
    const float rstd = rsqrtf(wave_sum(ss, lane) * (1.f / DM) + EPS);
#pragma unroll
    for (int j = 0; j < 8; ++j) { const int col = row_col<SRC16>(j, lane); const f32x4 gg = *(const f32x4*)(g + col);
        float o[4];
#pragma unroll
        for (int e = 0; e < 4; ++e) o[e] = R.v[j][e] * rstd * gg[e] * (1.f + scp[col + e]) + shp[col + e];
        u32x2 w; w.x = pk2(o[0], o[1]); w.y = pk2(o[2], o[3]); *(u32x2*)(orow + col) = w; }
}
__device__ __forceinline__ void p1_phase(const Args& a, LAS unsigned char* lds, int tid, int wave, int lane) {
    unsigned char* ws = a.ws; const float* modp = (const float*)(ws + WS_MODP); const float* bada = a.in[3]; float* mod = (float*)(ws + WS_MOD);
    const int G = gridDim.x;
    for (int o = blockIdx.x * 512 + tid; o < 8 * NMOD; o += G * 512) { float s = bada[o % NMOD];
#pragma unroll 8
        for (int kc = 0; kc < 32; ++kc) s += modp[(size_t)kc * 8 * NMOD + o];
        mod[o] = s; }
    LAS float* ml = (LAS float*)lds;
    bf16* H = (bf16*)a.out;
    for (int it = blockIdx.x; it < MT / 64; it += G) {
        const int b = it / 32;
        __syncthreads();
        for (int o = tid; o < 4096; o += 512) { float s = bada[o];
#pragma unroll 8
            for (int kc = 0; kc < 32; ++kc) s += modp[(size_t)(kc * 8 + b) * NMOD + o];
            ml[o] = s; }
        __syncthreads();
        for (int r = 0; r < 8; r += 2) { const int row = it * 64 + wave * 8 + r; RowRegs R0, R1;
            row_load(R0, a.in[0] + (size_t)row * DM, lane); row_load(R1, a.in[0] + (size_t)(row + 1) * DM, lane);
            norm_finish_bf16<const LAS float*>(R0, a.in[4], ml + 2048, ml, H + (size_t)row * DM, lane);
            norm_finish_bf16<const LAS float*>(R1, a.in[4], ml + 2048, ml, H + (size_t)(row + 1) * DM, lane); }
        __syncthreads();
        { const int rt = wave >> 1, ct = wave & 1, fr = lane & 15, quad = lane >> 4;
          const bf16* ap = H + (size_t)(it * 64 + rt * 16 + fr) * DM + quad * 8; const bf16* bp = (const bf16*)(ws + WS_WINLO) + (size_t)(12288 + ct * 16 + fr) * DM + quad * 8;
          f32x4 acc0 = {0.f, 0.f, 0.f, 0.f}, acc1 = {0.f, 0.f, 0.f, 0.f};
          for (int k0 = 0; k0 < 64; k0 += 8) { bf16x8 av[8], bv[8];
#pragma unroll
              for (int k = 0; k < 8; ++k) { av[k] = *(const bf16x8*)(ap + (k0 + k) * 32); bv[k] = *(const bf16x8*)(bp + (k0 + k) * 32); }
#pragma unroll
              for (int k = 0; k < 8; k += 2) { acc0 = __builtin_amdgcn_mfma_f32_16x16x32_bf16(av[k], bv[k], acc0, 0, 0, 0); acc1 = __builtin_amdgcn_mfma_f32_16x16x32_bf16(av[k + 1], bv[k + 1], acc1, 0, 0, 0); } }
          acc0 = acc0 + acc1; float* sp = (float*)(ws + WS_SMALL) + (size_t)(it * 64 + rt * 16 + quad * 4) * 32 + ct * 16 + fr;
#pragma unroll
          for (int i = 0; i < 4; ++i) sp[i * 32] = acc0[i]; }
    }
    __syncthreads();
}

#define LBAR() do { asm volatile("s_waitcnt lgkmcnt(0)" ::: "memory"); __builtin_amdgcn_s_barrier(); asm volatile("" ::: "memory"); } while (0)
#define MFMA16(a_, b_, c_) __builtin_amdgcn_mfma_f32_16x16x32_bf16((a_), (b_), (c_), 0, 0, 0)
__device__ __forceinline__ void gla_prep_unit(const Args& a, LAS unsigned char* lds, int unit, int tid) {
    unsigned char* ws = a.ws;
    const int b = unit >> 7, h = (unit >> 5) & 3, c = unit & 31, R0 = b * SEQ + c * 64;
    LAS float* GA = (LAS float*)lds; LAS float* HT = (LAS float*)(lds + 4096); LAS float* BLR = (LAS float*)(lds + 5120);
    const int dk = tid & 255, half = tid >> 8;
    const float* wup = a.in[6]; float wu[16];
#pragma unroll
    for (int r = 0; r < 16; ++r) wu[r] = wup[r * 1024 + h * 256 + dk];
    const float ba = a.in[7][h * 256 + dk];
    bf16* GQ = (bf16*)(ws + WS_GQ); bf16* GK = (bf16*)(ws + WS_GK); const float* SMALL = (const float*)(ws + WS_SMALL);
    __syncthreads();
    { const f32x2 g2 = *(const f32x2*)(SMALL + (size_t)(R0 + (tid >> 3)) * 32 + (tid & 7) * 2); *(LAS f32x2*)(GA + (tid >> 3) * 16 + (tid & 7) * 2) = g2; }
    bf16* qp = GQ + (size_t)(R0 + half * 32) * 1024 + h * 256 + dk; bf16* kp = GK + (size_t)(R0 + half * 32) * 1024 + h * 256 + dk;
    __syncthreads();
    float bc[32]; float run = 0.f;
#pragma unroll
    for (int tt = 0; tt < 32; ++tt) { const int t = half * 32 + tt; float z = ba;
#pragma unroll
        for (int r4 = 0; r4 < 4; ++r4) { const f32x4 g = *(const LAS f32x4*)(GA + t * 16 + r4 * 4); z += g[0] * wu[r4 * 4] + g[1] * wu[r4 * 4 + 1] + g[2] * wu[r4 * 4 + 2] + g[3] * wu[r4 * 4 + 3]; }
        run += logsig(z) * 0.0625f; bc[tt] = run; }
    if (half == 0) HT[dk] = run;
    __syncthreads();
    if (half == 1) { const float add = HT[dk];
#pragma unroll
        for (int tt = 0; tt < 32; ++tt) bc[tt] += add;
        BLR[dk] = bc[31]; ((float*)(ws + WS_EBLG))[(size_t)unit * 256 + dk] = __expf(bc[31]); }
    __syncthreads();
    const float bl = BLR[dk];
    bf16* kdt = (bf16*)(ws + WS_KDTG) + ((size_t)unit * 256 + dk) * 64 + half * 32;
    float qv[32], kv[32];
#pragma unroll
    for (int tt = 0; tt < 32; ++tt) { qv[tt] = bf2f(qp[(size_t)tt * 1024]); kv[tt] = bf2f(kp[(size_t)tt * 1024]); }
    __syncthreads();
    const int dkp = (dk & ~31) | (((dk >> 2) & 3) << 3) | (((dk >> 4) & 1) << 2) | (dk & 3);
    bf16* qw = qp - dk + dkp; bf16* kw = kp - dk + dkp;
#pragma unroll
    for (int t8 = 0; t8 < 4; ++t8) { float kd[8];
#pragma unroll
        for (int e = 0; e < 8; ++e) { const int tt = t8 * 8 + e;
            qw[(size_t)tt * 1024] = (bf16)f2bf(qv[tt] * __expf(bc[tt]) * 0.0625f);
            kw[(size_t)tt * 1024] = (bf16)f2bf(kv[tt] * __expf(-bc[tt]));
            kd[e] = kv[tt] * __expf(bl - bc[tt]); }
        u32x4 w; w.x = pk2(kd[0], kd[1]); w.y = pk2(kd[2], kd[3]); w.z = pk2(kd[4], kd[5]); w.w = pk2(kd[6], kd[7]);
        *(u32x4*)(kdt + t8 * 8) = w; }
}
__device__ __forceinline__ void cum_item(const Args& a, LAS unsigned char* lds, int item, int tid, int wave, int lane) {
    unsigned char* ws = a.ws; const int b = item >> 4, h = item & 15; LAS float* WTOT = (LAS float*)lds; const float* SMALL = (const float*)(ws + WS_SMALL);
    const float bf_ = a.in[9][h]; float p[4]; float run = 0.f;
#pragma unroll
    for (int e = 0; e < 4; ++e) { run += logsig(SMALL[(size_t)(b * SEQ + tid * 4 + e) * 32 + 16 + h] + bf_); p[e] = run; }
    float sc = run;
#pragma unroll
    for (int o = 1; o < 64; o <<= 1) { const float t = __builtin_bit_cast(float, __builtin_amdgcn_ds_bpermute(((lane - o) & 63) << 2, __builtin_bit_cast(int, sc))); if (lane >= o) sc += t; }
    __syncthreads();
    if (lane == 63) WTOT[wave] = sc;
    __syncthreads();
    float off = sc - run;
    for (int w = 0; w < wave; ++w) off += WTOT[w];
    const float NL = -1.4426950408889634f;
    *(f32x4*)((float*)(ws + WS_CUMG) + (size_t)item * SEQ + tid * 4) = (f32x4){(off + p[0]) * NL, (off + p[1]) * NL, (off + p[2]) * NL, (off + p[3]) * NL};
}
__device__ __forceinline__ void gla_item(const Args& a, LAS unsigned char* lds, int item, int tid_in, int wave, int lane_in) {
    unsigned char* ws = a.ws;
    int tid = tid_in; asm volatile("" : "+v"(tid)); const int lane = tid & 63; (void)lane_in;
    const int bh = item >> 3, slice = item & 7, b = bh >> 2, h = bh & 3;
    LAS unsigned char* QD = lds; LAS unsigned char* KI = lds + 33792; LAS unsigned char* KDT = lds + 67584; LAS unsigned char* VT = lds + 104448; LAS unsigned char* AT = lds + 113664;
    LAS float* OP = (LAS float*)(lds + 122880); LAS float* EBL = (LAS float*)(lds + 139264); LAS unsigned char* OT = lds + 140288;
    const int fr = lane & 15, quad = lane >> 4;
    const bf16* GQ = (const bf16*)(ws + WS_GQ); const bf16* GK = (const bf16*)(ws + WS_GK); const bf16* GVT = (const bf16*)(ws + WS_GVT);
    const bf16* KDTG = (const bf16*)(ws + WS_KDTG); const float* EBLG = (const float*)(ws + WS_EBLG); bf16* OA = (bf16*)(ws + WS_OA);
    const int hf = wave >> 2, dvt = wave & 3;
    f32x4 st[8];
#pragma unroll
    for (int r = 0; r < 8; ++r) st[r] = (f32x4){0.f, 0.f, 0.f, 0.f};
    const bf16* gq = GQ + (size_t)(b * SEQ + (tid >> 5)) * 1024 + h * 256 + (tid & 31) * 8;
    const bf16* gk = GK + (size_t)(b * SEQ + (tid >> 5)) * 1024 + h * 256 + (tid & 31) * 8;
    const bf16* gd = KDTG + ((size_t)(bh * 32) * 256 + (tid >> 3)) * 64 + (tid & 7) * 8;
    const bf16* gv = GVT + ((size_t)(b * 32) * DM + h * 512 + slice * 64 + (tid >> 3)) * 64 + (tid & 7) * 8;
    const float* ge = EBLG + (size_t)(bh * 32) * 256 + (tid & 255);
    struct PF { u32x4 q[4], k[4], d[4], v; float e; };
    PF pfA;
#define GLA_LOAD(P_, c_) do { _Pragma("unroll") for (int i = 0; i < 4; ++i) { P_.q[i] = *(const u32x4*)(gq + (size_t)((c_) * 64 + i * 16) * 1024); P_.k[i] = *(const u32x4*)(gk + (size_t)((c_) * 64 + i * 16) * 1024); \
        P_.d[i] = *(const u32x4*)(gd + (size_t)(c_) * 256 * 64 + (size_t)i * 64 * 64); } P_.v = *(const u32x4*)(gv + (size_t)(c_) * DM * 64); P_.e = ge[(size_t)(c_) * 256]; } while (0)
#define GLA_STORE(P_) do { _Pragma("unroll") for (int i = 0; i < 4; ++i) { *(LAS u32x4*)(QD + ((tid >> 5) + i * 16) * 528 + (tid & 31) * 16) = P_.q[i]; *(LAS u32x4*)(KI + ((tid >> 5) + i * 16) * 528 + (tid & 31) * 16) = P_.k[i]; \
        *(LAS u32x4*)(KDT + ((tid >> 3) + i * 64) * 144 + (tid & 7) * 16) = P_.d[i]; } *(LAS u32x4*)(VT + (tid >> 3) * 144 + (tid & 7) * 16) = P_.v; if (tid < 256) EBL[tid] = P_.e; } while (0)
    GLA_LOAD(pfA, 0);
    const LAS unsigned char* QDl = QD + fr * 528 + quad * 16; const LAS unsigned char* KIl = KI + fr * 528 + quad * 16;
    const LAS unsigned char* KDl = KDT + (hf * 128 + fr) * 144 + quad * 16; const LAS unsigned char* VTl = VT + (dvt * 16 + fr) * 144 + quad * 16; const LAS unsigned char* ATl = AT + fr * 144 + hf * 64 + quad * 16;
    for (int c = 0; c < 32; ++c) {
        const int R0 = b * SEQ + c * 64;
        LBAR();
        if (c > 0) { const u32x4 w = *(const LAS u32x4*)(OT + (tid >> 3) * 144 + (tid & 7) * 16);
            *(u32x4*)(OA + (size_t)(R0 - 64 + (tid >> 3)) * DM + h * 512 + slice * 64 + (tid & 7) * 8) = w; }
        GLA_STORE(pfA); if (c + 1 < 32) GLA_LOAD(pfA, c + 1);
        LBAR();
        { const int tq = wave >> 1, sq0 = 2 * (wave & 1);
          f32x4 acc0 = {0.f, 0.f, 0.f, 0.f}, acc1 = {0.f, 0.f, 0.f, 0.f}, acc2 = {0.f, 0.f, 0.f, 0.f}, acc3 = {0.f, 0.f, 0.f, 0.f};
          if (sq0 <= tq) { bf16x8 qa[8], kb[8];
#pragma unroll
              for (int ks = 0; ks < 8; ++ks) { qa[ks] = *(const LAS bf16x8*)(QDl + tq * 16 * 528 + ks * 64); kb[ks] = *(const LAS bf16x8*)(KIl + sq0 * 16 * 528 + ks * 64); }
              __builtin_amdgcn_sched_barrier(0);
#pragma unroll
              for (int ks = 0; ks < 8; ks += 2) { acc0 = MFMA16(qa[ks], kb[ks], acc0); acc1 = MFMA16(qa[ks + 1], kb[ks + 1], acc1); }
              __builtin_amdgcn_sched_barrier(0);
              if (sq0 + 1 <= tq) {
#pragma unroll
                  for (int ks = 0; ks < 8; ++ks) kb[ks] = *(const LAS bf16x8*)(KIl + (sq0 + 1) * 16 * 528 + ks * 64);
                  __builtin_amdgcn_sched_barrier(0);
#pragma unroll
                  for (int ks = 0; ks < 8; ks += 2) { acc2 = MFMA16(qa[ks], kb[ks], acc2); acc3 = MFMA16(qa[ks + 1], kb[ks + 1], acc3); }
                  __builtin_amdgcn_sched_barrier(0); } }
          acc0 = acc0 + acc1; acc2 = acc2 + acc3;
#pragma unroll
          for (int i = 0; i < 4; ++i) { const int t = tq * 16 + quad * 4 + i, s = sq0 * 16 + fr;
              *(LAS bf16*)(AT + t * 144 + s * 2) = (bf16)f2bf((s <= t) ? acc0[i] : 0.f);
              *(LAS bf16*)(AT + t * 144 + (s + 16) * 2) = (bf16)f2bf((s + 16 <= t) ? acc2[i] : 0.f); } }
        LBAR();
        f32x4 o[4];
        { bf16x8 aa[4], qa[2][4]; const bf16x8 vb = *(const LAS bf16x8*)(VTl + hf * 64);
#pragma unroll
          for (int tq = 0; tq < 4; ++tq) { aa[tq] = *(const LAS bf16x8*)(ATl + tq * 16 * 144); qa[0][tq] = *(const LAS bf16x8*)(QDl + tq * 16 * 528 + hf * 256); }
          __builtin_amdgcn_sched_barrier(0);
#pragma unroll
          for (int tq = 0; tq < 4; ++tq) o[tq] = MFMA16(aa[tq], vb, ((f32x4){0.f, 0.f, 0.f, 0.f}));
#pragma unroll
          for (int kk = 0; kk < 4; ++kk) { u32x4 bw; bw.x = pk2(st[2 * kk][0], st[2 * kk][1]); bw.y = pk2(st[2 * kk][2], st[2 * kk][3]); bw.z = pk2(st[2 * kk + 1][0], st[2 * kk + 1][1]); bw.w = pk2(st[2 * kk + 1][2], st[2 * kk + 1][3]);
              const bf16x8 bv = __builtin_bit_cast(bf16x8, bw);
              if (kk < 3) {
#pragma unroll
                  for (int tq = 0; tq < 4; ++tq) qa[(kk + 1) & 1][tq] = *(const LAS bf16x8*)(QDl + tq * 16 * 528 + hf * 256 + (kk + 1) * 64); }
              __builtin_amdgcn_sched_barrier(0);
#pragma unroll
              for (int tq = 0; tq < 4; ++tq) o[tq] = MFMA16(qa[kk & 1][tq], bv, o[tq]);
              __builtin_amdgcn_sched_barrier(0); } }
        if (hf == 1) {
#pragma unroll
            for (int tq = 0; tq < 4; ++tq)
#pragma unroll
                for (int i = 0; i < 4; ++i) OP[(tq * 16 + quad * 4 + i) * 64 + dvt * 16 + fr] = o[tq][i]; }
        { bf16x8 ka[2][4]; const bf16x8 v0 = *(const LAS bf16x8*)VTl, v1 = *(const LAS bf16x8*)(VTl + 64); f32x4 e4[8];
#pragma unroll
          for (int rt = 0; rt < 8; ++rt) e4[rt] = *(const LAS f32x4*)(EBL + hf * 128 + rt * 16 + quad * 4);
#pragma unroll
          for (int r2 = 0; r2 < 2; ++r2) { ka[0][2 * r2] = *(const LAS bf16x8*)(KDl + r2 * 16 * 144); ka[0][2 * r2 + 1] = *(const LAS bf16x8*)(KDl + r2 * 16 * 144 + 64); }
          __builtin_amdgcn_sched_barrier(0);
#pragma unroll
          for (int rp = 0; rp < 4; ++rp) {
              if (rp < 3) {
#pragma unroll
                  for (int r2 = 0; r2 < 2; ++r2) { ka[(rp + 1) & 1][2 * r2] = *(const LAS bf16x8*)(KDl + (2 * rp + 2 + r2) * 16 * 144); ka[(rp + 1) & 1][2 * r2 + 1] = *(const LAS bf16x8*)(KDl + (2 * rp + 2 + r2) * 16 * 144 + 64); } }
              st[2 * rp] = st[2 * rp] * e4[2 * rp]; st[2 * rp + 1] = st[2 * rp + 1] * e4[2 * rp + 1];
              __builtin_amdgcn_sched_barrier(0);
              st[2 * rp] = MFMA16(ka[rp & 1][0], v0, st[2 * rp]); st[2 * rp + 1] = MFMA16(ka[rp & 1][2], v0, st[2 * rp + 1]);
              st[2 * rp] = MFMA16(ka[rp & 1][1], v1, st[2 * rp]); st[2 * rp + 1] = MFMA16(ka[rp & 1][3], v1, st[2 * rp + 1]);
              __builtin_amdgcn_sched_barrier(0); } }
        LBAR();
        if (hf == 0) { float opv[16];
#pragma unroll
            for (int tq = 0; tq < 4; ++tq)
#pragma unroll
                for (int i = 0; i < 4; ++i) opv[tq * 4 + i] = OP[(tq * 16 + quad * 4 + i) * 64 + dvt * 16 + fr];
            __builtin_amdgcn_sched_barrier(0);
#pragma unroll
            for (int tq = 0; tq < 4; ++tq)
#pragma unroll
                for (int i = 0; i < 4; ++i) *(LAS bf16*)(OT + (tq * 16 + quad * 4 + i) * 144 + (dvt * 16 + fr) * 2) = (bf16)f2bf(o[tq][i] + opv[tq * 4 + i]); }
    }
    LBAR();
    { const u32x4 w = *(const LAS u32x4*)(OT + (tid >> 3) * 144 + (tid & 7) * 16);
      *(u32x4*)(OA + (size_t)(b * SEQ + 31 * 64 + (tid >> 3)) * DM + h * 512 + slice * 64 + (tid & 7) * 8) = w; }
#undef GLA_LOAD
#undef GLA_STORE
    __syncthreads();
}

#define FOX_DMA(jj_, st_) do { _Pragma("unroll") for (int i_ = 0; i_ < 2; ++i_) { \
        __builtin_amdgcn_global_load_lds((const unsigned*)(kgp[i_] + (size_t)(jj_) * 64 * DM), (LAS unsigned*)(lds + (st_) * 32768 + (wave * 2 + i_) * 1024), 16, 0, 0); \
        __builtin_amdgcn_global_load_lds((const unsigned*)(vgp[i_] + (size_t)(jj_) * DM * 64), (LAS unsigned*)(lds + (st_) * 32768 + 16384 + (wave * 2 + i_) * 1024), 16, 0, 0); } } while (0)
template <int ST>
__device__ __forceinline__ void fox_tile(LAS unsigned char* lds, const LAS float* CUM, int wave, int lane, int fr, int quad, int j, int ntile, int q0,
                                         const bf16* const (&kgp)[2], const bf16* const (&vgp)[2], const unsigned (&kro)[4], const unsigned (&vro)[2],
                                         const bf16x8 (&qf)[2][4], f32x4 (&o)[2][8], float (&mrun)[2], float (&lrun)[2]) {
    const float SCL = 0.08838834764831845f * 1.4426950408889634f;
    if (j + 1 < ntile) FOX_DMA(j + 1, ST ^ 1);
    if (j * 64 <= q0 + 31) {
    const LAS unsigned char* KTs = lds + ST * 32768; const LAS unsigned char* VTs = lds + ST * 32768 + 16384;
    f32x4 s[2][4]; bf16x8 kf[4];
#define KFRAG(i_) (*(const LAS bf16x8*)(KTs + ((i_) >> 2) * 4096 + kro[(i_) & 3]))
    kf[0] = KFRAG(0); kf[1] = KFRAG(1); kf[2] = KFRAG(2);
#pragma unroll
    for (int mt = 0; mt < 4; ++mt) { s[0][mt] = (f32x4){0.f, 0.f, 0.f, 0.f}; s[1][mt] = (f32x4){0.f, 0.f, 0.f, 0.f}; }
#pragma unroll
    for (int i = 0; i < 16; ++i) {
        if (i + 3 < 16) kf[(i + 3) & 3] = KFRAG(i + 3);
        __builtin_amdgcn_sched_barrier(0);
        s[0][i >> 2] = MFMA16(kf[i & 3], qf[0][i & 3], s[0][i >> 2]); s[1][i >> 2] = MFMA16(kf[i & 3], qf[1][i & 3], s[1][i >> 2]);
        __builtin_amdgcn_sched_barrier(0); }
#undef KFRAG
    bf16x8 vf[3];
#define VFRAG(i_) (*(const LAS bf16x8*)(VTs + ((i_) >> 1) * 2048 + vro[(i_) & 1]))
    vf[0] = VFRAG(0); vf[1] = VFRAG(1);
    const bool diag = (j * 64 + 63 > q0);
    bf16x8 pb[2][2];
#pragma unroll
    for (int sub = 0; sub < 2; ++sub) { const int q = q0 + sub * 16 + fr; float mx = -__builtin_inff();
#pragma unroll
        for (int mt = 0; mt < 4; ++mt) { const f32x4 ck = *(const LAS f32x4*)(CUM + j * 64 + mt * 16 + quad * 4);
#pragma unroll
            for (int i = 0; i < 4; ++i) { float v = fmaf(s[sub][mt][i], SCL, ck[i]);
                if (diag && (j * 64 + mt * 16 + quad * 4 + i > q)) v = -__builtin_inff();
                s[sub][mt][i] = v; mx = fmaxf(mx, v); } }
        mx = fmaxf(mx, shx(mx, 16, lane)); mx = fmaxf(mx, shx(mx, 32, lane));
        if (!__all(mx - mrun[sub] <= 8.f)) {
            const float mn = fmaxf(mrun[sub], mx), alpha = __builtin_amdgcn_exp2f(mrun[sub] - mn); mrun[sub] = mn; lrun[sub] *= alpha;
#pragma unroll
            for (int d = 0; d < 8; ++d) o[sub][d] = o[sub][d] * alpha; }
        const float mn = mrun[sub]; float ps = 0.f;
#pragma unroll
        for (int mt = 0; mt < 4; ++mt)
#pragma unroll
            for (int i = 0; i < 4; ++i) { const float p = __builtin_amdgcn_exp2f(s[sub][mt][i] - mn); s[sub][mt][i] = p; ps += p; }
        lrun[sub] += ps;
#pragma unroll
        for (int k2 = 0; k2 < 2; ++k2) { u32x4 w; w.x = pk2(s[sub][2 * k2][0], s[sub][2 * k2][1]); w.y = pk2(s[sub][2 * k2][2], s[sub][2 * k2][3]);
            w.z = pk2(s[sub][2 * k2 + 1][0], s[sub][2 * k2 + 1][1]); w.w = pk2(s[sub][2 * k2 + 1][2], s[sub][2 * k2 + 1][3]); pb[sub][k2] = __builtin_bit_cast(bf16x8, w); } }
    __builtin_amdgcn_sched_barrier(0);
#pragma unroll
    for (int i = 0; i < 16; ++i) {
        if (i + 2 < 16) vf[(i + 2) % 3] = VFRAG(i + 2);
        __builtin_amdgcn_sched_barrier(0);
        o[0][i >> 1] = MFMA16(vf[i % 3], pb[0][i & 1], o[0][i >> 1]); o[1][i >> 1] = MFMA16(vf[i % 3], pb[1][i & 1], o[1][i >> 1]);
        __builtin_amdgcn_sched_barrier(0); }
#undef VFRAG
    }
    asm volatile("s_waitcnt vmcnt(0)" ::: "memory");
    LBAR();
}
__device__ __forceinline__ void fox_item(const Args& a, LAS unsigned char* lds, int item, int tid_in, int wave, int lane_in) {
    unsigned char* ws = a.ws;
    int tid = tid_in; asm volatile("" : "+v"(tid)); (void)lane_in;
    const int bh = item >> 2, x = item & 3, b = bh >> 4, h = bh & 15;
    LAS float* CUM = (LAS float*)(lds + 65536);
    const bf16* FQ = (const bf16*)(ws + WS_FQ); const bf16* FK = (const bf16*)(ws + WS_FK); const bf16* FVT = (const bf16*)(ws + WS_FVT);
    bf16* OB = (bf16*)((unsigned char*)a.out + 64 * MiB);
    __syncthreads();
    *(LAS f32x4*)(CUM + tid * 4) = *(const f32x4*)((const float*)(ws + WS_CUMG) + (size_t)bh * SEQ + tid * 4);
    __syncthreads();
    for (int pass = 0; pass < 2; ++pass) {
        const int lane = my_lane(), fr = lane & 15, quad = lane >> 4;
        const int qb = pass ? 7 - x : x, ntile = (qb + 1) * 4, q0 = qb * 256 + wave * 32;
        bf16x8 qf[2][4]; float mrun[2], lrun[2]; f32x4 o[2][8];
#pragma unroll
        for (int sub = 0; sub < 2; ++sub) { const int q = q0 + sub * 16 + fr; mrun[sub] = -1e30f; lrun[sub] = 0.f;
#pragma unroll
            for (int ks = 0; ks < 4; ++ks) qf[sub][ks] = *(const bf16x8*)(FQ + (size_t)(b * SEQ + q) * DM + h * 128 + ks * 32 + quad * 8);
#pragma unroll
            for (int d = 0; d < 8; ++d) o[sub][d] = (f32x4){0.f, 0.f, 0.f, 0.f}; }
        const bf16* kgp[2]; const bf16* vgp[2];
#pragma unroll
        for (int i = 0; i < 2; ++i) { const int L = (wave * 2 + i) * 64 + lane;
            { const int row = L >> 4, c = (L & 15) ^ (row & 15); kgp[i] = FK + (size_t)(b * SEQ + row) * DM + h * 128 + c * 8; }
            { const int row = L >> 3, c = (L & 7) ^ ((row >> 1) & 7); vgp[i] = FVT + ((size_t)(b * 32) * DM + h * 128 + row) * 64 + c * 8; } }
        unsigned kro[4], vro[2];
#pragma unroll
        for (int ks = 0; ks < 4; ++ks) kro[ks] = (unsigned)(fr * 256 + (((ks * 4 + quad) ^ fr) << 4));
#pragma unroll
        for (int k2 = 0; k2 < 2; ++k2) vro[k2] = (unsigned)(fr * 128 + (((k2 * 4 + quad) ^ ((fr >> 1) & 7)) << 4));
        FOX_DMA(0, 0);
        asm volatile("s_waitcnt vmcnt(0)" ::: "memory");
        LBAR();
        for (int j = 0; j < ntile; j += 2) {
            fox_tile<0>(lds, CUM, wave, lane, fr, quad, j, ntile, q0, kgp, vgp, kro, vro, qf, o, mrun, lrun);
            fox_tile<1>(lds, CUM, wave, lane, fr, quad, j + 1, ntile, q0, kgp, vgp, kro, vro, qf, o, mrun, lrun);
        }
#pragma unroll
        for (int sub = 0; sub < 2; ++sub) { float lt = lrun[sub]; lt += shx(lt, 16, lane); lt += shx(lt, 32, lane); const float inv = 1.f / lt; bf16* op = OB + (size_t)(b * SEQ + q0 + sub * 16 + fr) * DM + h * 128 + quad * 4;
#pragma unroll
            for (int d = 0; d < 8; ++d) { u32x2 w; w.x = pk2(o[sub][d][0] * inv, o[sub][d][1] * inv); w.y = pk2(o[sub][d][2] * inv, o[sub][d][3] * inv); *(u32x2*)(op + d * 16) = w; } }
    }
    __syncthreads();
}
#undef FOX_DMA

__device__ __forceinline__ void fix_row(const Args& a, int row, int lane) {
    unsigned char* ws = a.ws; bf16* OA = (bf16*)(ws + WS_OA) + (size_t)row * DM; const bf16* GG = (const bf16*)(ws + WS_GG) + (size_t)row * DM;
    const f32x4 g0 = *(const f32x4*)(a.in[8] + lane * 8), g1 = *(const f32x4*)(a.in[8] + lane * 8 + 4);
#pragma unroll
    for (int hh = 0; hh < 4; ++hh) { const u32x4 w = *(const u32x4*)(OA + hh * 512 + lane * 8); const u32x4 gw = *(const u32x4*)(GG + hh * 512 + lane * 8);
        float v[8] = {bflo(w.x), bfhi(w.x), bflo(w.y), bfhi(w.y), bflo(w.z), bfhi(w.z), bflo(w.w), bfhi(w.w)};
        float gv[8] = {bflo(gw.x), bfhi(gw.x), bflo(gw.y), bfhi(gw.y), bflo(gw.z), bfhi(gw.z), bflo(gw.w), bfhi(gw.w)};
        float ss = 0.f;
#pragma unroll
        for (int e = 0; e < 8; ++e) ss += v[e] * v[e];
        const float rstd = rsqrtf(wave_sum(ss, lane) * (1.f / 512.f) + EPS);
        float r[8];
#pragma unroll
        for (int e = 0; e < 8; ++e) { const float gl = e < 4 ? g0[e] : g1[e - 4]; r[e] = v[e] * rstd * gl * (gv[e] * sigmoidf_(gv[e])); }
        u32x4 ow; ow.x = pk2(r[0], r[1]); ow.y = pk2(r[2], r[3]); ow.z = pk2(r[4], r[5]); ow.w = pk2(r[6], r[7]);
        *(u32x4*)(OA + hh * 512 + lane * 8) = ow; }
}
__device__ __forceinline__ void final_finish(const RowRegs& R, float* orow, const float* g, int lane) {
    float ss = 0.f;
#pragma unroll
    for (int j = 0; j < 8; ++j) ss += (R.v[j][0] * R.v[j][0] + R.v[j][1] * R.v[j][1]) + (R.v[j][2] * R.v[j][2] + R.v[j][3] * R.v[j][3]);
    const float rstd = rsqrtf(wave_sum(ss, lane) * (1.f / DM) + EPS);
#pragma unroll
    for (int j = 0; j < 8; ++j) { const int col = row_col<true>(j, lane); const f32x4 gg = *(const f32x4*)(g + col); *(f32x4*)(orow + col) = R.v[j] * rstd * gg; }
}

#define XB_TMO      128
#define XB_XCNT(j)  (256  + 64 * (j))
#define XB_XSUB(j)  (1280 + 64 * (j))
#define XB_XGEN(j)  (2304 + 64 * (j))
#define XB_TOP      3328
#define XB_TOPGEN   3392
#define XCD_BAR_WORDS 3456
#define XB_SPIN_CAP (1u << 18)

__device__ __forceinline__ unsigned xb_ld(unsigned* p)              { return __hip_atomic_load(p, __ATOMIC_RELAXED, __HIP_MEMORY_SCOPE_AGENT); }
__device__ __forceinline__ unsigned xb_add(unsigned* p, unsigned v) { return __hip_atomic_fetch_add(p, v, __ATOMIC_RELAXED, __HIP_MEMORY_SCOPE_AGENT); }
__device__ __forceinline__ unsigned xb_xcc_id() { return (unsigned)__builtin_amdgcn_s_getreg((3 << 11) | 20) & 0xFu; }
#define XB_SPIN(cond, bar) do { unsigned _sp = 0; while (cond) { __builtin_amdgcn_s_sleep(1); \
    if ((++_sp & 255u) == 0u) { if (xb_ld(&(bar)[XB_TMO])) break; if (_sp > XB_SPIN_CAP) { atomicAdd(&(bar)[XB_TMO], 1u); break; } } } } while (0)

struct XcdBarrier {
    unsigned* bar; unsigned x;
    volatile LAS unsigned* st;
};

__device__ __forceinline__ XcdBarrier xcd_barrier_post(unsigned* bar, volatile LAS unsigned* st, int tid_) {
    XcdBarrier b; b.bar = bar; b.x = xb_xcc_id(); b.st = st;
    if (tid_ == 0) st[2] = xb_add(&bar[XB_XCNT(b.x)], 1u);
    return b;
}
__device__ __forceinline__ void xcd_barrier_complete(unsigned* bar, unsigned x, unsigned& nloc, unsigned& nx) {
    const unsigned G = gridDim.x * gridDim.y * gridDim.z;
    unsigned sum, cnt, mine, sp = 0u;
    for (;;) {
        sum = 0u; cnt = 0u; mine = 0u;
#pragma unroll
        for (unsigned j = 0; j < 16; ++j) { const unsigned c = xb_ld(&bar[XB_XCNT(j)]); sum += c; cnt += (c > 0u) ? 1u : 0u; mine = (j == x) ? c : mine; }
        if (sum == G) break;
        __builtin_amdgcn_s_sleep(1);
        if ((++sp & 255u) == 0u) { if (xb_ld(&bar[XB_TMO])) break; if (sp > XB_SPIN_CAP) { atomicAdd(&bar[XB_TMO], 1u); break; } }
    }
    nloc = mine > 0u ? mine : 1u; nx = cnt > 0u ? cnt : 1u;
}

__device__ __forceinline__ void xcd_barrier(const XcdBarrier& b, int tid_) {
    asm volatile("s_waitcnt vmcnt(0)" ::: "memory");
    __syncthreads();
    if (tid_ == 0) {
        unsigned* bar = b.bar;
        __builtin_amdgcn_s_waitcnt(0);
        unsigned nloc = b.st[0], nx = b.st[1];
        if (nloc == 0u) { xcd_barrier_complete(bar, b.x, nloc, nx); b.st[0] = nloc; b.st[1] = nx; }
        const unsigned old = xb_add(&bar[XB_XSUB(b.x)], 1u);
        const unsigned gen = old / nloc;
        if (old + 1u == (gen + 1u) * nloc) {
            __builtin_amdgcn_fence(__ATOMIC_RELEASE, "agent");
            asm volatile("s_waitcnt vmcnt(0)" ::: "memory");
            const unsigned og = xb_add(&bar[XB_TOP], 1u);
            const unsigned tg = og / nx;
            if (og + 1u == (tg + 1u) * nx) xb_add(&bar[XB_TOPGEN], 1u);
            else XB_SPIN(xb_ld(&bar[XB_TOPGEN]) == tg, bar);
            __builtin_amdgcn_fence(__ATOMIC_ACQUIRE, "agent");
            xb_add(&bar[XB_XGEN(b.x)], 1u);
            asm volatile("s_waitcnt vmcnt(0)" ::: "memory");
        } else {
            XB_SPIN(xb_ld(&bar[XB_XGEN(b.x)]) == gen, bar);
            __builtin_amdgcn_fence(__ATOMIC_ACQUIRE, "agent");
            asm volatile("s_waitcnt vmcnt(0)" ::: "memory");
        }
    }
    __syncthreads();
}

#define WGM_G1A 4
#define WGM_G1B 4
#define WGM_DUAL 4
#define WGM_G3 4
#define WGM_G4 4
#define WGM_G5 4
#define REP_P0 1
#define REP_G1A 1
#define REP_GLA 1
#define REP_FOX 1
#define REP_G4 1
#define REP_G3 1
#define REP_P1 1
#define REP_P7 1
#define REP_G1B 1
#define REP_G2A 1
#define REP_G2B 1
__global__ void __launch_bounds__(512, 2) hybrid_fwd(Args a) {
    extern __shared__ __attribute__((aligned(16))) unsigned char lds_raw[];
    LAS unsigned char* lds = (LAS unsigned char*)lds_raw;
    cg::grid_group grid = cg::this_grid();
    const int G = gridDim.x, NGW = G * 8;
    const int wave0 = __builtin_amdgcn_readfirstlane((int)(threadIdx.x >> 6));
#define MYTID() (wave0 * 64 + my_lane())
    unsigned* barw = (unsigned*)(a.ws + WS_CTL);
    volatile LAS unsigned* MISC = (volatile LAS unsigned*)(lds + LDS_BYTES - 64);
    { const int t0 = MYTID(); if (t0 < 16) MISC[t0] = 0u;
      if (blockIdx.x == 0) for (int i = t0; i < XCD_BAR_WORDS; i += 512) barw[i] = 0u; }
    __syncthreads();
#define FRESH() int tid = MYTID(); asm volatile("" : "+v"(tid)); const int lane = tid & 63, wave = __builtin_amdgcn_readfirstlane(tid >> 6), gw = blockIdx.x * 8 + wave; (void)lane; (void)gw
    unsigned char* ws = a.ws;
    const float* MOD = (const float*)(ws + WS_MOD);

    for (int rep = 0; rep < REP_P0; ++rep) { FRESH(); p0_phase(a, lds, gw, NGW, wave, lane); __syncthreads(); }
    grid.sync();
    const XcdBarrier xbar = xcd_barrier_post(barw, MISC, MYTID());
#define GRID_BAR() do { unsigned long long bp_ = (unsigned long long)(a.ws + WS_CTL); asm volatile("" : "+s"(bp_)); XcdBarrier xb_ = xbar; xb_.bar = (unsigned*)bp_; xcd_barrier(xb_, MYTID()); } while (0)
    for (int rep = 0; rep < REP_P1; ++rep) { FRESH(); p1_phase(a, lds, tid, wave, lane); }
    GRID_BAR();
    for (int rep = 0; rep < REP_G1A; ++rep) {
        pg8::Gemm g{(const bf16*)a.out, (const bf16*)(ws + WS_WINLO), MT, N1A, DM, nullptr, nullptr}; pg8::StaticOrder S; S.init(MT, N1A, G, (int)blockIdx.x, WGM_G1A);
        EpiProj E{ws};
        pg8::gemm_phase<EpiProj, pg8::StaticOrder, true, true>(lds, g, S, E, MYTID());
    }
    GRID_BAR();
    { FRESH(); for (int it = blockIdx.x; it < 1024; it += G) gla_prep_unit(a, lds, it, tid);
      __syncthreads();
      for (int it = blockIdx.x; it < 128; it += G) cum_item(a, lds, it, tid, wave, lane); }
    GRID_BAR();
    int vb = (int)blockIdx.x;
    if (G == 256) { bool even = true;
        for (unsigned j = 0; j < 8; ++j) even = even && (xb_ld(&barw[XB_XCNT(j)]) == 32u);
        const unsigned xr = MISC[2];
        vb = (even && xbar.x < 8u && xr < 32u) ? (int)(xbar.x * 32u + xr) : (int)((blockIdx.x & 7) * 32 + (blockIdx.x >> 3)); }
    vb = __builtin_amdgcn_readfirstlane(vb);
    for (int rep = 0; rep < REP_GLA; ++rep)
    for (int it = vb; it < 256; it += G) { FRESH(); gla_item(a, lds, it, tid, wave, lane); }
    for (int rep = 0; rep < REP_FOX; ++rep)
    for (int it = vb; it < 512; it += G) { FRESH(); fox_item(a, lds, it, tid, wave, lane); }
    GRID_BAR();
    {
        FRESH();
        for (int row = gw; row < MT; row += NGW) fix_row(a, row, lane);
        LAS float* scr = (LAS float*)(lds + wave * 16896);
        for (int it = gw; it < 32 * 128; it += NGW) tr_plain(a.in[14], DM, DFF, (bf16*)(ws + WS_W1), it, scr, lane);
        for (int it = gw; it < 128 * 32; it += NGW) tr_plain(a.in[15], DFF, DM, (bf16*)(ws + WS_W2), it, scr, lane);
        { unsigned* z = (unsigned*)(ws + WS_ROWSS); for (int i = gw * 64 + lane; i < (229376 - 65536) / 4; i += NGW * 64) z[i] = 0u; }
        __syncthreads();
        pg8::Gemm g{(const bf16*)a.out, (const bf16*)(ws + WS_WINHI), MT, N1B, DM, nullptr, nullptr}; pg8::StaticOrder S; S.init(MT, N1B, G, (int)blockIdx.x, WGM_G1B);
        EpiGen<0> E{(bf16*)(ws + WS_SGA), 2048, nullptr, nullptr, nullptr, nullptr, nullptr};
        for (int rep = 0; rep < REP_G1B; ++rep) pg8::gemm_phase<EpiGen<0>, pg8::StaticOrder, true, true>(lds, g, S, E, MYTID());
    }
    GRID_BAR();
    {
        pg8::DualOrder S; S.init(MT, DM, G, (int)blockIdx.x, WGM_DUAL);
        pg8::Gemm g{(const bf16*)(ws + WS_OA), (const bf16*)(ws + WS_WA), MT, DM, DM, (const bf16*)((unsigned char*)a.out + 64 * MiB), (const bf16*)(ws + WS_WB)};
        EpiDual E{(bf16*)(ws + WS_MG), (const bf16*)(ws + WS_SGA), (const bf16*)(ws + WS_SGB)};
        pg8::gemm_phase<EpiDual, pg8::DualOrder, true, true>(lds, g, S, E, MYTID());
    }
    GRID_BAR();
    for (int rep = 0; rep < REP_G3; ++rep) {
        pg8::Gemm g{(const bf16*)(ws + WS_MG), (const bf16*)(ws + WS_WO), MT, DM, DM, nullptr, nullptr}; pg8::StaticOrder S; S.init(MT, DM, G, (int)blockIdx.x, WGM_G3);
        if (G == 256) {
            EpiMid E{(bf16*)(ws + WS_X1B), (bf16*)(ws + WS_H2), a.in[0], MOD, a.in[13], (float*)(ws + WS_ROWSS2), (unsigned*)(ws + WS_PCNT2), (LAS float*)(lds + 131072)};
            pg8::gemm_phase<EpiMid, pg8::StaticOrder, true, true>(lds, g, S, E, MYTID());
        } else {
            EpiGen<5> E{(bf16*)(ws + WS_X1B), 2048, nullptr, nullptr, a.in[0], nullptr, MOD + 2 * DM};
            pg8::gemm_phase<EpiGen<5>, pg8::StaticOrder, true, true>(lds, g, S, E, MYTID());
        }
    }
    GRID_BAR();
    if (G != 256) {
        FRESH();
        bf16* H2 = (bf16*)(ws + WS_H2);
        for (int row = 2 * gw; row < MT; row += 2 * NGW) { const float* mb = MOD + (size_t)(row / SEQ) * NMOD; RowRegs R0, R1;
            row_load_b16(R0, (const bf16*)(ws + WS_X1B) + (size_t)row * DM, lane); row_load_b16(R1, (const bf16*)(ws + WS_X1B) + (size_t)(row + 1) * DM, lane);
            norm_finish_bf16<const float*, true>(R0, a.in[13], mb + 4 * DM, mb + 3 * DM, H2 + (size_t)row * DM, lane);
            norm_finish_bf16<const float*, true>(R1, a.in[13], mb + 4 * DM, mb + 3 * DM, H2 + (size_t)(row + 1) * DM, lane); }
        __syncthreads();
        GRID_BAR();
    }
    for (int rep = 0; rep < REP_G4; ++rep) {
        pg8::Gemm g{(const bf16*)(ws + WS_H2), (const bf16*)(ws + WS_W1), MT, DFF, DM, nullptr, nullptr}; pg8::StaticOrder S; S.init(MT, DFF, G, (int)blockIdx.x, WGM_G4);
        EpiGen<4> E{(bf16*)(ws + WS_U), DFF, nullptr, nullptr, nullptr, nullptr, nullptr};
        pg8::gemm_phase<EpiGen<4>, pg8::StaticOrder, true, true>(lds, g, S, E, MYTID());
    }
    GRID_BAR();
    {
        pg8::Gemm g{(const bf16*)(ws + WS_U), (const bf16*)(ws + WS_W2), MT, DM, DFF, nullptr, nullptr}; pg8::StaticOrder S; S.init(MT, DM, G, (int)blockIdx.x, WGM_G5);
        if (G == 256) {
            EpiFinal E{a.out, (const bf16*)(ws + WS_X1B), MOD + 5 * DM, a.in[16], (float*)(ws + WS_ROWSS), (unsigned*)(ws + WS_PCNT), (LAS float*)(lds + 131072)};
            pg8::gemm_phase<EpiFinal, pg8::StaticOrder, true, true>(lds, g, S, E, MYTID());
        } else {
            EpiGen<6> E{(bf16*)(ws + WS_X2B), 2048, (const bf16*)(ws + WS_X1B), nullptr, nullptr, nullptr, MOD + 5 * DM};
            pg8::gemm_phase<EpiGen<6>, pg8::StaticOrder, true, true>(lds, g, S, E, MYTID());
        }
    }
    if (G != 256) {
        GRID_BAR();
        { FRESH(); for (int row = 2 * gw; row < MT; row += 2 * NGW) { RowRegs R0, R1; const bf16* X2B = (const bf16*)(ws + WS_X2B); row_load_b16(R0, X2B + (size_t)row * DM, lane); row_load_b16(R1, X2B + (size_t)(row + 1) * DM, lane);
            final_finish(R0, a.out + (size_t)row * DM, a.in[16], lane); final_finish(R1, a.out + (size_t)(row + 1) * DM, a.in[16], lane); } }
    }
}

extern "C" void kernel_launch(void* const* d_in, const int* in_sizes, int n_in, void* d_out, int out_size, void* d_ws, size_t ws_size, hipStream_t stream) {
    static int grid = 0;
    if (grid == 0) {
        if (n_in != 17 || out_size != MT * DM || ws_size < WS_END) { fprintf(stderr, "kernel_launch: unexpected shapes (n_in %d out %d ws %zu)\n", n_in, out_size, ws_size); grid = -1; return; }
        int dev = 0, cus = 0, per_cu = 0;
        (void)hipGetDevice(&dev); (void)hipDeviceGetAttribute(&cus, hipDeviceAttributeMultiprocessorCount, dev);
        (void)hipFuncSetAttribute((const void*)hybrid_fwd, hipFuncAttributeMaxDynamicSharedMemorySize, LDS_BYTES);
        (void)hipOccupancyMaxActiveBlocksPerMultiprocessor(&per_cu, (const void*)hybrid_fwd, 512, LDS_BYTES);
        if (per_cu < 1) { fprintf(stderr, "kernel_launch: occupancy query says %d blocks per CU\n", per_cu); per_cu = 1; }
        (void)hipGetLastError();
        grid = cus > 0 ? cus : 256;
    }
    if (grid < 0) return;
    Args a{};
    for (int i = 0; i < 17; ++i) a.in[i] = (const float*)d_in[i];
    a.out = (float*)d_out; a.ws = (unsigned char*)d_ws;
    void* args[] = {&a};
    hipError_t e = hipLaunchCooperativeKernel((const void*)hybrid_fwd, dim3(grid), dim3(512), args, LDS_BYTES, stream);
    if (e != hipSuccess) fprintf(stderr, "cooperative launch failed: %s (grid %d)\n", hipGetErrorString(e), grid);
}
```
